# Optimizing an MI355X kernel written in HIP

```python
import math
import jax, jax.numpy as jnp
from jax import lax
import numpy as np

D_MODEL = 1024
BATCH = 32
SEQ = 2048
DEPTH = 1

GLA_HEADS = 4
GLA_DK = 64
GLA_DV = 128
GLA_GATE_RANK = 16
GLA_GATE_NORMALIZER = 16.0
GLA_CHUNK = 64
DIFF_HEADS = 4
DIFF_DK = 64
DIFF_DV = 128
Q_BLOCK = 128
REL_BUCKETS = 32
REL_MAX_DIST = 128
D_FF = -(-8 * D_MODEL // (3 * 256)) * 256
EPS = 1e-6

GLA_Q_COLS = GLA_HEADS * GLA_DK
GLA_K_COLS = GLA_HEADS * GLA_DK
GLA_V_COLS = GLA_HEADS * GLA_DV
GLA_OG_COLS = GLA_HEADS * GLA_DV
DIFF_Q_COLS = DIFF_HEADS * 2 * DIFF_DK
DIFF_K_COLS = DIFF_HEADS * 2 * DIFF_DK
DIFF_V_COLS = DIFF_HEADS * DIFF_DV
MIX_WIDTH = GLA_HEADS * GLA_DV + DIFF_HEADS * DIFF_DV
IN_COLS = (GLA_Q_COLS + GLA_K_COLS + GLA_V_COLS + GLA_OG_COLS + GLA_GATE_RANK
           + DIFF_Q_COLS + DIFF_K_COLS + DIFF_V_COLS)

kernel_name = "hybrid_gla_diffattn_t5bias_sandwich"


def rms_norm(x, g):
    xf = x.astype(jnp.float32)
    y = xf * lax.rsqrt(jnp.mean(xf * xf, axis=-1, keepdims=True) + EPS)
    return (y * g.astype(jnp.float32)).astype(x.dtype)


def split_columns(proj):
    sizes = [GLA_Q_COLS, GLA_K_COLS, GLA_V_COLS, GLA_OG_COLS, GLA_GATE_RANK,
             DIFF_Q_COLS, DIFF_K_COLS, DIFF_V_COLS]
    points = [int(p) for p in np.cumsum(sizes)[:-1]]
    return jnp.split(proj, points, axis=-1)


def gla_mixer(q, k, v, log_a, og, g_head):
    B, S = q.shape[0], q.shape[1]
    C = GLA_CHUNK
    N = S // C
    f32 = jnp.float32

    def chunk(t):
        return t.astype(f32).reshape(B, N, C, t.shape[2], t.shape[3]).transpose(0, 3, 1, 2, 4)

    qc = chunk(q) * (GLA_DK ** -0.5)
    kc, vc, ac = chunk(k), chunk(v), chunk(log_a)
    b = jnp.cumsum(ac, axis=3)
    b_last = b[:, :, :, C - 1:C, :]
    b_ref = b[:, :, :, C // 2 - 1:C // 2, :]

    scores = jnp.einsum('bhnid,bhnjd->bhnij', qc * jnp.exp(b - b_ref), kc * jnp.exp(b_ref - b))
    causal = jnp.tril(jnp.ones((C, C), dtype=bool))
    scores = jnp.where(causal, scores, 0.0)
    o_intra = jnp.einsum('bhnij,bhnjv->bhniv', scores, vc)

    u = jnp.einsum('bhnjd,bhnjv->bhndv', kc * jnp.exp(b_last - b), vc)
    decay = jnp.exp(b_last[:, :, :, 0, :])

    def step(state, inp):
        d_n, u_n = inp
        return d_n[..., None] * state + u_n, state

    s0 = jnp.zeros((B, q.shape[2], GLA_DK, GLA_DV), f32)
    _, s_prev = lax.scan(step, s0, (decay.transpose(2, 0, 1, 3), u.transpose(2, 0, 1, 3, 4)))
    s_prev = s_prev.transpose(1, 2, 0, 3, 4)
    o_inter = jnp.einsum('bhnid,bhndv->bhniv', qc * jnp.exp(b), s_prev)

    o = (o_intra + o_inter).transpose(0, 2, 3, 1, 4).reshape(B, S, q.shape[2], GLA_DV)
    o = rms_norm(o, g_head) * jax.nn.silu(og.astype(f32))
    return o.reshape(B, S, q.shape[2] * GLA_DV).astype(v.dtype)


def t5_causal_bucket(rel):
    n = jnp.maximum(rel, 0)
    max_exact = REL_BUCKETS // 2
    nf = jnp.maximum(n, 1).astype(jnp.float32)
    large = max_exact + (jnp.log(nf / max_exact) / math.log(REL_MAX_DIST / max_exact)
                         * (REL_BUCKETS - max_exact)).astype(jnp.int32)
    large = jnp.minimum(large, REL_BUCKETS - 1)
    return jnp.where(n < max_exact, n, large)


def diff_attention(q, k, v, lam, rel_table, g_head, lambda_init):
    B, S, H = q.shape[0], q.shape[1], q.shape[2]
    qh = (q * (DIFF_DK ** -0.5)).transpose(0, 2, 3, 1, 4)
    kh = k.transpose(0, 2, 3, 1, 4)
    vh = v.transpose(0, 2, 1, 3)
    lam32 = lam.astype(jnp.float32)
    outs = []
    for qb in range(S // Q_BLOCK):
        q0 = qb * Q_BLOCK
        kv_len = q0 + Q_BLOCK
        logits = jnp.einsum('bhmqd,bhmkd->bhmqk', qh[:, :, :, q0:kv_len],
                            kh[:, :, :, :kv_len]).astype(jnp.float32)
        q_pos = jnp.arange(q0, kv_len)
        k_pos = jnp.arange(kv_len)
        rel = q_pos[:, None] - k_pos[None, :]
        bias = rel_table.astype(jnp.float32)[t5_causal_bucket(rel)].transpose(2, 0, 1)
        logits = logits + bias[None, :, None]
        logits = jnp.where((rel >= 0)[None, None, None], logits, -jnp.inf)
        p = jax.nn.softmax(logits, axis=-1)
        a = p[:, :, 0] - lam32 * p[:, :, 1]
        outs.append(jnp.einsum('bhqk,bhkv->bhqv', a.astype(v.dtype), vh[:, :, :kv_len]))
    o = jnp.concatenate(outs, axis=2)
    o = rms_norm(o, g_head) * (1.0 - lambda_init)
    return o.transpose(0, 2, 1, 3).reshape(B, S, H * DIFF_DV).astype(v.dtype)


def setup_inputs(seed: int = 0) -> dict:
    key = jax.random.key(seed)
    ks = jax.random.split(key, 20)
    f32 = jnp.float32

    def nrm(k, shape, scale):
        return jax.random.normal(k, shape, f32) * scale

    def gain(k, shape):
        return jnp.ones(shape, f32) + 0.01 * jax.random.normal(k, shape, f32)

    return {
        "x": jax.random.normal(ks[0], (BATCH, SEQ, D_MODEL), f32),
        "w_in": nrm(ks[1], (DEPTH, D_MODEL, IN_COLS), D_MODEL ** -0.5),
        "w_gk_up": nrm(ks[2], (DEPTH, GLA_GATE_RANK, GLA_HEADS * GLA_DK), GLA_GATE_RANK ** -0.5),
        "b_gk": nrm(ks[3], (DEPTH, GLA_HEADS * GLA_DK), 0.01),
        "lambda_q1": nrm(ks[4], (DEPTH, DIFF_DK), 0.1),
        "lambda_k1": nrm(ks[5], (DEPTH, DIFF_DK), 0.1),
        "lambda_q2": nrm(ks[6], (DEPTH, DIFF_DK), 0.1),
        "lambda_k2": nrm(ks[7], (DEPTH, DIFF_DK), 0.1),
        "rel_bias": nrm(ks[8], (REL_BUCKETS, DIFF_HEADS), 0.5),
        "g_gla_head": gain(ks[9], (DEPTH, GLA_DV)),
        "g_diff_head": gain(ks[10], (DEPTH, DIFF_DV)),
        "w_out": nrm(ks[11], (DEPTH, MIX_WIDTH, D_MODEL), MIX_WIDTH ** -0.5),
        "pre_mix_g": gain(ks[12], (DEPTH, D_MODEL)),
        "post_mix_g": gain(ks[13], (DEPTH, D_MODEL)),
        "w_gate": nrm(ks[14], (DEPTH, D_MODEL, D_FF), D_MODEL ** -0.5),
        "w_up": nrm(ks[15], (DEPTH, D_MODEL, D_FF), D_MODEL ** -0.5),
        "w_down": nrm(ks[16], (DEPTH, D_FF, D_MODEL), D_FF ** -0.5),
        "pre_ffn_g": gain(ks[17], (DEPTH, D_MODEL)),
        "post_ffn_g": gain(ks[18], (DEPTH, D_MODEL)),
    }


def reference(x, w_in, w_gk_up, b_gk, lambda_q1, lambda_k1, lambda_q2, lambda_k2,
              rel_bias, g_gla_head, g_diff_head, w_out, pre_mix_g, post_mix_g,
              w_gate, w_up, w_down, pre_ffn_g, post_ffn_g):
    B, S, _ = x.shape
    for l in range(DEPTH):
        lambda_init = 0.8 - 0.6 * math.exp(-0.3 * l)
        h = rms_norm(x, pre_mix_g[l])
        proj = jnp.einsum('bsd,dc->bsc', h, w_in[l])
        gq, gk, gv, gog, glow, dq, dk, dv = split_columns(proj)
        log_a = jax.nn.log_sigmoid(
            (jnp.einsum('bsr,rc->bsc', glow, w_gk_up[l]) + b_gk[l]).astype(jnp.float32)
        ) / GLA_GATE_NORMALIZER
        gla_out = gla_mixer(
            gq.reshape(B, S, GLA_HEADS, GLA_DK),
            gk.reshape(B, S, GLA_HEADS, GLA_DK),
            gv.reshape(B, S, GLA_HEADS, GLA_DV),
            log_a.reshape(B, S, GLA_HEADS, GLA_DK),
            gog.reshape(B, S, GLA_HEADS, GLA_DV),
            g_gla_head[l])
        lam = (jnp.exp(jnp.sum(lambda_q1[l].astype(jnp.float32) * lambda_k1[l].astype(jnp.float32)))
               - jnp.exp(jnp.sum(lambda_q2[l].astype(jnp.float32) * lambda_k2[l].astype(jnp.float32)))
               + lambda_init)
        diff_out = diff_attention(
            dq.reshape(B, S, DIFF_HEADS, 2, DIFF_DK),
            dk.reshape(B, S, DIFF_HEADS, 2, DIFF_DK),
            dv.reshape(B, S, DIFF_HEADS, DIFF_DV),
            lam, rel_bias, g_diff_head[l], lambda_init)
        mixed = jnp.concatenate([gla_out, diff_out], axis=-1)
        mix = jnp.einsum('bsc,cd->bsd', mixed, w_out[l])
        x = x + rms_norm(mix, post_mix_g[l])
        h = rms_norm(x, pre_ffn_g[l])
        f = jax.nn.silu(jnp.einsum('bsd,df->bsf', h, w_gate[l])) * jnp.einsum('bsd,df->bsf', h, w_up[l])
        f = jnp.einsum('bsf,fd->bsd', f, w_down[l])
        x = x + rms_norm(f, post_ffn_g[l])
    return x
```

```cpp
#include <hip/hip_runtime.h>
#include <cstdio>
#include <cstdint>
namespace pg8 {
#define PG8_LAS __attribute__((address_space(3)))
typedef unsigned short bf16_t;
typedef short bf16x8 __attribute__((ext_vector_type(8)));
typedef float f32x4 __attribute__((ext_vector_type(4)));
typedef unsigned u32x4 __attribute__((ext_vector_type(4)));
constexpr int BM = 256, BK = 64, HALF = 128, HTB = HALF * BK * 2  , STAGE_BYTES = 8 * HTB, NXCD = 8, WGM = 8;

__host__ __device__ __forceinline__ int lds_byte(int r, int c) { const int st = (r >> 4) * 2 + (c >> 5), rr = r & 15, cc = c & 31, ob = rr * 64 + cc * 2; return st * 1024 + (ob ^ (((ob >> 9) & 1) << 5)); }
__host__ __device__ __forceinline__ void stage_rc(int b, int& R, int& C) { const int st = b / 1024, sb = b % 1024, swz = sb ^ (((sb >> 9) & 1) << 5); R = (st >> 1) * 16 + swz / 64; C = (st & 1) * 32 + (swz % 64) / 2; }
__host__ __device__ __forceinline__ int perm32(int rho) { const int n = rho >> 4, i = rho & 15; return 8 * (i >> 2) + 4 * n + (i & 3); }

struct Unit { int pm, pn; };
struct Gemm { const bf16_t* A; const bf16_t* Bt; int M, N, K; };

struct StaticOrder {
    int nM, nN, nwg, G, c;
    __host__ __device__ void init(int M, int N, int G_, int c_) { nM = M / BM; nN = N / BM; nwg = nM * nN; G = G_; c = c_; }
    __host__ __device__ bool next(int i, Unit& u) const {
        const long L = (long)i * G + c; if (L >= nwg) return false;
        int wgid = (int)L; { const int q = nwg / NXCD, r = nwg % NXCD, xcd = wgid % NXCD, off = wgid / NXCD; wgid = (xcd < r ? xcd * (q + 1) : r * (q + 1) + (xcd - r) * q) + off; }
        const int nig = WGM * nN, gid = wgid / nig, fm = gid * WGM, gsz = (nM - fm) < WGM ? (nM - fm) : WGM;
        u.pm = fm + ((wgid % nig) % gsz); u.pn = (wgid % nig) / gsz; return true;
    }
    __device__ __forceinline__ void a_ready(const Unit&) const {}
    __device__ __forceinline__ void done(const Unit&) const {}
};

__device__ __forceinline__ unsigned cvt_pk_bf16(float lo, float hi) { unsigned r; asm volatile("v_cvt_pk_bf16_f32 %0, %1, %2" : "=v"(r) : "v"(lo), "v"(hi)); return r; }
constexpr float LOG2E_F = 1.4426950408889634f;

struct EpiF32 {
    static constexpr bool PERM = false, AFTER_DRAIN = false;
    float* C; int ldc;
    __device__ __forceinline__ void operator()(const f32x4 (&acc)[2][2][4][2], const Unit& u, int wr, int wc, int fr, int fq) const {
        const int row0 = u.pm * BM + wr * 64 + fr, col0 = u.pn * BM + wc * 32 + 4 * fq;
#pragma unroll
        for (int ai = 0; ai < 2; ++ai)
#pragma unroll
            for (int m = 0; m < 4; ++m) { float* rowp = C + (size_t)(row0 + ai * HALF + m * 16) * ldc + col0;
#pragma unroll
                for (int bj = 0; bj < 2; ++bj)
#pragma unroll
                    for (int n = 0; n < 2; ++n) *(f32x4*)(rowp + bj * HALF + n * 16) = acc[ai][bj][m][n]; }
    }
};

struct EpiProj {
    static constexpr bool PERM = true, AFTER_DRAIN = false;
    bf16_t* O; int ldc; const float* b_gk;
    __device__ __forceinline__ void operator()(const f32x4 (&acc)[2][2][4][2], const Unit& u, int wr, int wc, int fr, int fq) const {
        const int row0 = u.pm * BM + wr * 64 + fr; const int col0 = u.pn * BM + wc * 32 + 8 * fq;
        const float sc = (u.pn == 0) ? 0.125f : ((u.pn == 6 || u.pn == 7) ? 0.125f * LOG2E_F : 1.0f);
        const bool gate = (u.pn == 12);
        f32x4 bv[2][2];
#pragma unroll
        for (int bj = 0; bj < 2; ++bj)
#pragma unroll
            for (int n = 0; n < 2; ++n) bv[bj][n] = gate ? *(const f32x4*)(b_gk + (col0 - 3072) + bj * HALF + 4 * n) : (f32x4){0.f, 0.f, 0.f, 0.f};
#pragma unroll
        for (int ai = 0; ai < 2; ++ai)
#pragma unroll
            for (int m = 0; m < 4; ++m) { bf16_t* rowp = O + (size_t)(row0 + ai * HALF + m * 16) * ldc + col0;
#pragma unroll
                for (int bj = 0; bj < 2; ++bj) { f32x4 v0 = acc[ai][bj][m][0], v1 = acc[ai][bj][m][1];
                    if (gate) {
                        v0 += bv[bj][0]; v1 += bv[bj][1];
#pragma unroll
                        for (int e = 0; e < 4; ++e) {
                            { const float z = v0[e]; const float t = __expf(-fabsf(z)); v0[e] = (fminf(z, 0.f) - __logf(1.0f + t)) * (LOG2E_F / 16.0f); }
                            { const float z = v1[e]; const float t = __expf(-fabsf(z)); v1[e] = (fminf(z, 0.f) - __logf(1.0f + t)) * (LOG2E_F / 16.0f); }
                        }
                    } else { v0 = v0 * sc; v1 = v1 * sc; }
                    u32x4 w; w.x = cvt_pk_bf16(v0[0], v0[1]); w.y = cvt_pk_bf16(v0[2], v0[3]); w.z = cvt_pk_bf16(v1[0], v1[1]); w.w = cvt_pk_bf16(v1[2], v1[3]);
                    *(u32x4*)(rowp + bj * HALF) = w; } }
    }
};

struct EpiSwiGLU {
    static constexpr bool PERM = true, AFTER_DRAIN = false;
    bf16_t* H; int ldc;
    __device__ __forceinline__ void operator()(const f32x4 (&acc)[2][2][4][2], const Unit& u, int wr, int wc, int fr, int fq) const {
        const int row0 = u.pm * BM + wr * 64 + fr; const int col0 = u.pn * HALF + wc * 32 + 8 * fq;
#pragma unroll
        for (int ai = 0; ai < 2; ++ai)
#pragma unroll
            for (int m = 0; m < 4; ++m) { bf16_t* rowp = H + (size_t)(row0 + ai * HALF + m * 16) * ldc + col0;
                f32x4 h0, h1;
#pragma unroll
                for (int e = 0; e < 4; ++e) {
                    { const float g = acc[ai][0][m][0][e], up = acc[ai][1][m][0][e]; h0[e] = g * __builtin_amdgcn_rcpf(1.0f + __builtin_amdgcn_exp2f(-g * LOG2E_F)) * up; }
                    { const float g = acc[ai][0][m][1][e], up = acc[ai][1][m][1][e]; h1[e] = g * __builtin_amdgcn_rcpf(1.0f + __builtin_amdgcn_exp2f(-g * LOG2E_F)) * up; }
                }
                u32x4 w; w.x = cvt_pk_bf16(h0[0], h0[1]); w.y = cvt_pk_bf16(h0[2], h0[3]); w.z = cvt_pk_bf16(h1[0], h1[1]); w.w = cvt_pk_bf16(h1[2], h1[3]);
                *(u32x4*)rowp = w; }
    }
};
template <class Epi, class Sched, bool ALIGN_EPI = false, bool SP2 = false>
__device__ __forceinline__ void gemm_phase(PG8_LAS unsigned char* lds, const Gemm g, const Sched& S, const Epi& E) {
    const int tid = threadIdx.x, wid = __builtin_amdgcn_readfirstlane(tid >> 6), lane = tid & 63, wr = wid >> 2, wc = wid & 3, fr = lane & 15, fq = lane >> 4;
    const int K = g.K, nt = K / BK;
    unsigned voffA[2], voffB[2];
#pragma unroll
    for (int i = 0; i < 2; ++i) { int R, C; stage_rc(tid * 16 + i * 8192, R, C); const int Rb = Epi::PERM ? ((R & ~31) + perm32(R & 31)) : R;
        voffA[i] = (unsigned)(R * K + C) * 2u; voffB[i] = (unsigned)(Rb * K + C) * 2u; }
    const size_t kstep = (size_t)(BK * 2);
    const size_t hstep = (size_t)HALF * K * 2;
    const size_t tstep = 2 * hstep;
    const unsigned ldsw = (unsigned)wid * 1024u;
    const int aoff = lds_byte(wr * 64 + fr, fq * 8), boff = lds_byte(wc * 32 + fr, fq * 8);
#define PG8_SA(b, h) (((b) * 2 + (h)) * HTB)
#define PG8_SB(b, h) ((4 + (b) * 2 + (h)) * HTB)
#define PG8_STAGE(bufoff, gbase, voff) do { _Pragma("unroll") for (int _i = 0; _i < 2; ++_i) \
        __builtin_amdgcn_global_load_lds((const unsigned*)((const char*)(gbase) + (voff)[_i]), (PG8_LAS unsigned*)(lds + (bufoff) + ldsw + _i * 8192), 16, 0, 0); } while (0)
#define PG8_LDA(dst, b, h) do { _Pragma("unroll") for (int m = 0; m < 4; ++m) _Pragma("unroll") for (int k = 0; k < 2; ++k) dst[m][k] = *(const PG8_LAS bf16x8*)(lds + PG8_SA(b, h) + aoff + m * 2048 + k * 1024); } while (0)
#define PG8_LDB(dst, b, h) do { _Pragma("unroll") for (int n = 0; n < 2; ++n) _Pragma("unroll") for (int k = 0; k < 2; ++k) dst[n][k] = *(const PG8_LAS bf16x8*)(lds + PG8_SB(b, h) + boff + n * 2048 + k * 1024); } while (0)
#define PG8_MMA(ai, bj, At, Bt) do { __builtin_amdgcn_s_setprio(1); _Pragma("unroll") for (int m = 0; m < 4; ++m) _Pragma("unroll") for (int n = 0; n < 2; ++n) _Pragma("unroll") for (int k = 0; k < 2; ++k) \
        acc[ai][bj][m][n] = __builtin_amdgcn_mfma_f32_16x16x32_bf16(Bt[n][k], At[m][k], acc[ai][bj][m][n], 0, 0, 0); __builtin_amdgcn_s_setprio(0); } while (0)
#define PG8_WAIT_V(n) asm volatile("s_waitcnt vmcnt(" #n ")" ::: "memory")
#define PG8_WAIT_L(n) asm volatile("s_waitcnt lgkmcnt(" #n ")" ::: "memory")
#define PG8_BAR __builtin_amdgcn_s_barrier()
#define PG8_SCHED __builtin_amdgcn_sched_barrier(0)
    Unit cur, nxt; int ui = 0;
    if (!S.next(0, cur)) return;
    f32x4 acc[2][2][4][2];
#pragma unroll
    for (int a = 0; a < 2; ++a)
#pragma unroll
        for (int b = 0; b < 2; ++b)
#pragma unroll
            for (int m = 0; m < 4; ++m)
#pragma unroll
                for (int n = 0; n < 2; ++n) acc[a][b][m][n] = (f32x4){0.f, 0.f, 0.f, 0.f};
    bf16x8 At[4][2], B0[2][2], B1[2][2];
    const char* cA = (const char*)g.A + (size_t)cur.pm * tstep; const char* cB = (const char*)g.Bt + (size_t)cur.pn * tstep;
    S.a_ready(cur);
    if constexpr (SP2) {
        PG8_STAGE(PG8_SB(0, 0), cB, voffB); PG8_STAGE(PG8_SB(0, 1), cB + hstep, voffB); PG8_STAGE(PG8_SA(0, 0), cA, voffA); PG8_STAGE(PG8_SA(0, 1), cA + hstep, voffA);
        if (wr == 1) PG8_BAR;
        PG8_WAIT_V(2); PG8_BAR;
        PG8_STAGE(PG8_SB(1, 0), cB + kstep, voffB); PG8_STAGE(PG8_SA(1, 0), cA + kstep, voffA); PG8_STAGE(PG8_SB(1, 1), cB + hstep + kstep, voffB);
        PG8_WAIT_V(6); PG8_BAR;
    } else {
        PG8_STAGE(PG8_SB(0, 0), cB, voffB); PG8_STAGE(PG8_SA(0, 0), cA, voffA); PG8_STAGE(PG8_SB(0, 1), cB + hstep, voffB); PG8_STAGE(PG8_SA(0, 1), cA + hstep, voffA);
        if (wr == 1) PG8_BAR;
        PG8_WAIT_V(4); PG8_BAR;
        PG8_STAGE(PG8_SB(1, 0), cB + kstep, voffB); PG8_STAGE(PG8_SA(1, 0), cA + kstep, voffA); PG8_STAGE(PG8_SB(1, 1), cB + hstep + kstep, voffB);
        PG8_WAIT_V(6); PG8_BAR;
    }
    for (;;) {
        const bool has_next = S.next(ui + 1, nxt);
        const char* nA = has_next ? (const char*)g.A + (size_t)nxt.pm * tstep : cA; const char* nB = has_next ? (const char*)g.Bt + (size_t)nxt.pn * tstep : cB;
        for (int t = 0; t < nt; t += 2) {
            const bool last = (t == nt - 2);
            const char* a1 = cA + (size_t)(t + 1) * kstep;
            const char* a2 = last ? nA : cA + (size_t)(t + 2) * kstep; const char* b2 = last ? nB : cB + (size_t)(t + 2) * kstep;
            const char* a3 = a2 + kstep; const char* b3 = b2 + kstep;
            if (last && has_next) S.a_ready(nxt);
            if constexpr (SP2) {
            PG8_LDB(B0, 0, 0); PG8_LDB(B1, 0, 1); PG8_SCHED; PG8_LDA(At, 0, 0); PG8_STAGE(PG8_SA(1, 1), a1 + hstep, voffA);
            PG8_WAIT_V(8); PG8_WAIT_L(0); PG8_BAR; PG8_MMA(0, 0, At, B0); PG8_MMA(0, 1, At, B1); PG8_BAR; PG8_SCHED;
            PG8_LDA(At, 0, 1); PG8_STAGE(PG8_SB(0, 0), b2, voffB); PG8_STAGE(PG8_SB(0, 1), b2 + hstep, voffB); PG8_STAGE(PG8_SA(0, 0), a2, voffA);
            PG8_WAIT_V(8); PG8_WAIT_L(0); PG8_BAR; PG8_MMA(1, 0, At, B0); PG8_MMA(1, 1, At, B1); PG8_BAR; PG8_SCHED;
            PG8_LDB(B0, 1, 0); PG8_LDB(B1, 1, 1); PG8_SCHED; PG8_LDA(At, 1, 0); PG8_STAGE(PG8_SA(0, 1), a2 + hstep, voffA);
            PG8_WAIT_V(8); PG8_WAIT_L(0); PG8_BAR; PG8_MMA(0, 0, At, B0); PG8_MMA(0, 1, At, B1); PG8_BAR; PG8_SCHED;
            PG8_LDA(At, 1, 1); PG8_STAGE(PG8_SB(1, 0), b3, voffB); PG8_STAGE(PG8_SB(1, 1), b3 + hstep, voffB); PG8_STAGE(PG8_SA(1, 0), a3, voffA);
            PG8_WAIT_V(8); PG8_WAIT_L(0); PG8_BAR; PG8_MMA(1, 0, At, B0); PG8_MMA(1, 1, At, B1); PG8_BAR; PG8_SCHED;
            } else {
            PG8_LDB(B0, 0, 0); PG8_SCHED; PG8_LDA(At, 0, 0); PG8_STAGE(PG8_SA(1, 1), a1 + hstep, voffA);
            PG8_WAIT_L(8); PG8_BAR; PG8_WAIT_L(0); PG8_MMA(0, 0, At, B0); PG8_BAR; PG8_SCHED;
            PG8_LDB(B1, 0, 1); PG8_STAGE(PG8_SB(0, 0), b2, voffB);
            PG8_BAR; PG8_WAIT_L(0); PG8_MMA(0, 1, At, B1); PG8_BAR;
            PG8_LDA(At, 0, 1); PG8_STAGE(PG8_SA(0, 0), a2, voffA);
            PG8_BAR; PG8_WAIT_L(0); PG8_MMA(1, 0, At, B0); PG8_BAR; PG8_SCHED;
            PG8_STAGE(PG8_SB(0, 1), b2 + hstep, voffB);
            PG8_WAIT_V(6); PG8_BAR; PG8_MMA(1, 1, At, B1); PG8_BAR;
            PG8_LDB(B0, 1, 0); PG8_SCHED; PG8_LDA(At, 1, 0); PG8_STAGE(PG8_SA(0, 1), a2 + hstep, voffA);
            PG8_WAIT_L(8); PG8_BAR; PG8_WAIT_L(0); PG8_MMA(0, 0, At, B0); PG8_BAR; PG8_SCHED;
            PG8_LDB(B1, 1, 1); PG8_STAGE(PG8_SB(1, 0), b3, voffB);
            PG8_BAR; PG8_WAIT_L(0); PG8_MMA(0, 1, At, B1); PG8_BAR;
            PG8_LDA(At, 1, 1); PG8_STAGE(PG8_SA(1, 0), a3, voffA);
            PG8_BAR; PG8_WAIT_L(0); PG8_MMA(1, 0, At, B0); PG8_BAR; PG8_SCHED;
            PG8_STAGE(PG8_SB(1, 1), b3 + hstep, voffB);
            PG8_WAIT_V(6); PG8_BAR; PG8_MMA(1, 1, At, B1); PG8_BAR;
            }
        }
        if constexpr (ALIGN_EPI) { if (wr == 0) PG8_BAR; }
        if constexpr (!Epi::AFTER_DRAIN) { E(acc, cur, wr, wc, fr, fq); S.done(cur); }
        if (!has_next) break;
#pragma unroll
        for (int a = 0; a < 2; ++a)
#pragma unroll
            for (int b = 0; b < 2; ++b)
#pragma unroll
                for (int m = 0; m < 4; ++m)
#pragma unroll
                    for (int n = 0; n < 2; ++n) acc[a][b][m][n] = (f32x4){0.f, 0.f, 0.f, 0.f};
        cur = nxt; cA = nA; cB = nB; ++ui;
        if constexpr (ALIGN_EPI) { if (wr == 1) PG8_BAR; }
    }
    PG8_WAIT_V(0);
    if constexpr (!ALIGN_EPI) { if (wr == 0) PG8_BAR; }
    PG8_BAR;
    if constexpr (Epi::AFTER_DRAIN) { E.fused(acc, cur, wr, wc, fr, fq, lds, wid, lane); S.done(cur); }
#undef PG8_SA
#undef PG8_SB
#undef PG8_STAGE
#undef PG8_LDA
#undef PG8_LDB
#undef PG8_MMA
#undef PG8_WAIT_V
#undef PG8_WAIT_L
#undef PG8_BAR
#undef PG8_SCHED
}
}

constexpr int NWAVES = 8;
constexpr int BATCH = 32, SEQ = 2048, D = 1024, M = BATCH * SEQ;
constexpr int NPROJ = 3328;
constexpr int PC_GQ = 0, PC_GK = 256, PC_GV = 512, PC_GOG = 1024, PC_DQ = 1536, PC_DK = 2048, PC_DV = 2560, PC_LA = 3072;
constexpr int IN_COLS = 3088, GLOW_COL = 1536, GATE_RANK = 16;
constexpr int FF = 2816, NGU = 2 * FF;
constexpr float EPS = 1e-6f, LOG2E = 1.4426950408889634f;
constexpr float LAMBDA_INIT = 0.2f;

constexpr size_t MiB = 1u << 20;
constexpr size_t WS_CTL = 0, CTL_ZERO_BYTES = 1 * MiB;
constexpr size_t WS_WIN = 2 * MiB;
constexpr size_t WS_WOUT = 9 * MiB;
constexpr size_t WS_WGU = 11 * MiB;
constexpr size_t WS_WDN = 22 * MiB;
constexpr size_t WS_XCH = 28 * MiB;
constexpr size_t WS_PROJ = 64 * MiB;
constexpr size_t WS_HID = WS_PROJ;
constexpr size_t WS_XN = 480 * MiB;
constexpr size_t WS_MIXED = 608 * MiB;
constexpr size_t WS_TMP = 736 * MiB;
constexpr size_t WS_END = 992 * MiB;

constexpr int LDS_BYTES = 147456;

#define GAS __attribute__((address_space(1)))
#define LAS __attribute__((address_space(3)))
typedef unsigned short bf16;
typedef unsigned v4u __attribute__((ext_vector_type(4)));
typedef float f32x4 __attribute__((ext_vector_type(4)));
#define LDS_WAIT() asm volatile("s_waitcnt lgkmcnt(0)" ::: "memory")
__device__ __forceinline__ unsigned f2bf(float f) { unsigned u = __builtin_bit_cast(unsigned, f); return (u + 0x7fffu + ((u >> 16) & 1u)) >> 16; }
__device__ __forceinline__ unsigned pk2(float lo, float hi) { return f2bf(lo) | (f2bf(hi) << 16); }
__device__ __forceinline__ float bf2f(bf16 v) { return __builtin_bit_cast(float, (unsigned)v << 16); }
__device__ __forceinline__ float wave_sum(float v) {
#pragma unroll
    for (int o = 1; o < 64; o <<= 1) v += __shfl_xor(v, o);
    return v;
}

struct Frame {
    LAS unsigned char* lds;
    int tid, lane, wave, vcu, G;
    const float *x, *w_in, *w_gk_up, *b_gk, *lq1, *lk1, *lq2, *lk2, *rel_bias, *g_gla, *g_diff, *w_out, *pre_mix_g, *post_mix_g, *w_gate, *w_up, *w_down, *pre_ffn_g, *post_ffn_g;
    float* out;
    bf16 *Win_t, *Wout_t, *Wgu_t, *Wdn_t, *PROJ, *HID, *XN, *MIXED; float* TMP;
};

__device__ __forceinline__ void p0_transpose_item(const float* W, int K, int ldw, int src_col0, bf16* WT, int dst_row0, int kb, LAS float* scr, int lane) {
    const int k0 = 64 * kb;
#pragma unroll 8
    for (int i = 0; i < 32; ++i) { const int kk = 2 * i + (lane >> 5); scr[kk * 33 + (lane & 31)] = W[(size_t)(k0 + kk) * ldw + src_col0 + (lane & 31)]; }
    LDS_WAIT(); asm volatile("" ::: "memory");
    const int c = lane & 7;
#pragma unroll
    for (int j = 0; j < 4; ++j) { const int n = (lane >> 3) + 8 * j; const LAS float* s = scr + (8 * c) * 33 + n;
        v4u o; o.x = pk2(s[0 * 33], s[1 * 33]); o.y = pk2(s[2 * 33], s[3 * 33]); o.z = pk2(s[4 * 33], s[5 * 33]); o.w = pk2(s[6 * 33], s[7 * 33]);
        *(GAS v4u*)(WT + (size_t)(dst_row0 + n) * K + k0 + 8 * c) = o; }
    LDS_WAIT(); asm volatile("" ::: "memory");
}
__device__ __forceinline__ void rms_row_to_bf16(const float* xrow, const float* g, bf16* orow, int lane) {
    const GAS f32x4* xr = (const GAS f32x4*)xrow + lane; const GAS f32x4* gr = (const GAS f32x4*)g + lane;
    f32x4 v[4]; float s = 0.f;
#pragma unroll
    for (int j = 0; j < 4; ++j) { v[j] = xr[64 * j]; s += (v[j].x * v[j].x + v[j].y * v[j].y) + (v[j].z * v[j].z + v[j].w * v[j].w); }
    const float rstd = 1.0f / sqrtf(wave_sum(s) * (1.f / D) + EPS);
    GAS unsigned long long* o8 = (GAS unsigned long long*)orow + lane;
#pragma unroll
    for (int j = 0; j < 4; ++j) { const f32x4 gv = gr[64 * j]; const f32x4 y = v[j] * rstd * gv;
        o8[64 * j] = (unsigned long long)pk2(y.x, y.y) | ((unsigned long long)pk2(y.z, y.w) << 32); }
}
__device__ __forceinline__ void p0_prologue(Frame& F) {
    LAS float* scr = (LAS float*)(F.lds + F.wave * 16384);
    const int gw = F.vcu * NWAVES + F.wave, NGW = F.G * NWAVES;
    constexpr int KB_D = D / 64, KB_FF = FF / 64;
    constexpr int I_INA = KB_D * (1536 / 32), I_INB = I_INA, I_OUT = KB_D * (D / 32), I_G = KB_D * (FF / 32), I_U = I_G, I_DN = KB_FF * (D / 32);
    constexpr int NITEMS = I_INA + I_INB + I_OUT + I_G + I_U + I_DN;
    for (int it = gw; it < NITEMS; it += NGW) {
        int r = it;
        if (r < I_INA) { const int kb = r / 48, nb = r % 48; p0_transpose_item(F.w_in, D, IN_COLS, 32 * nb, F.Win_t, 32 * nb, kb, scr, F.lane); continue; } r -= I_INA;
        if (r < I_INB) { const int kb = r / 48, nb = r % 48; p0_transpose_item(F.w_in, D, IN_COLS, GLOW_COL + GATE_RANK + 32 * nb, F.Win_t, 1536 + 32 * nb, kb, scr, F.lane); continue; } r -= I_INB;
        if (r < I_OUT) { const int kb = r / 32, nb = r % 32; p0_transpose_item(F.w_out, D, D, 32 * nb, F.Wout_t, 32 * nb, kb, scr, F.lane); continue; } r -= I_OUT;
        if (r < I_G) { const int kb = r / 88, nb = r % 88, f0 = 32 * nb; p0_transpose_item(F.w_gate, D, FF, f0, F.Wgu_t, 256 * (f0 / 128) + (f0 % 128), kb, scr, F.lane); continue; } r -= I_G;
        if (r < I_U) { const int kb = r / 88, nb = r % 88, f0 = 32 * nb; p0_transpose_item(F.w_up, D, FF, f0, F.Wgu_t, 256 * (f0 / 128) + 128 + (f0 % 128), kb, scr, F.lane); continue; } r -= I_U;
        { const int kb = r / 32, nb = r % 32; p0_transpose_item(F.w_down, FF, D, 32 * nb, F.Wdn_t, 32 * nb, kb, scr, F.lane); }
    }
    for (int idx = (F.vcu * NWAVES * 64 + F.tid); idx < 256 * (D / 8); idx += F.G * NWAVES * 64) {
        const int n = idx / (D / 8), k0 = (idx % (D / 8)) * 8;
        float up[GATE_RANK];
#pragma unroll
        for (int r = 0; r < GATE_RANK; ++r) up[r] = F.w_gk_up[r * 256 + n];
        float o[8];
#pragma unroll
        for (int kk = 0; kk < 8; ++kk) { const float* wr = F.w_in + (size_t)(k0 + kk) * IN_COLS + GLOW_COL; float s = 0.f;
#pragma unroll
            for (int r = 0; r < GATE_RANK; ++r) s += wr[r] * up[r];
            o[kk] = s; }
        v4u w; w.x = pk2(o[0], o[1]); w.y = pk2(o[2], o[3]); w.z = pk2(o[4], o[5]); w.w = pk2(o[6], o[7]);
        *(GAS v4u*)(F.Win_t + (size_t)(PC_LA + n) * D + k0) = w;
    }
    for (int m = gw; m < M; m += NGW) rms_row_to_bf16(F.x + (size_t)m * D, F.pre_mix_g, F.XN + (size_t)m * D, F.lane);
}
__device__ __forceinline__ void p3b_rows(Frame& F) {
    const int gw = F.vcu * NWAVES + F.wave, NGW = F.G * NWAVES;
    for (int m = gw; m < M; m += NGW) {
        const GAS f32x4* tr = (const GAS f32x4*)(F.TMP + (size_t)m * D) + F.lane; const GAS f32x4* xr = (const GAS f32x4*)(F.x + (size_t)m * D) + F.lane;
        const GAS f32x4* g1 = (const GAS f32x4*)F.post_mix_g + F.lane; const GAS f32x4* g2 = (const GAS f32x4*)F.pre_ffn_g + F.lane;
        f32x4 v[4]; float s = 0.f;
#pragma unroll
        for (int j = 0; j < 4; ++j) { v[j] = tr[64 * j]; s += (v[j].x * v[j].x + v[j].y * v[j].y) + (v[j].z * v[j].z + v[j].w * v[j].w); }
        const float rstd = 1.0f / sqrtf(wave_sum(s) * (1.f / D) + EPS); float s2 = 0.f;
        GAS f32x4* orow = (GAS f32x4*)(F.out + (size_t)m * D) + F.lane;
#pragma unroll
        for (int j = 0; j < 4; ++j) { v[j] = xr[64 * j] + v[j] * rstd * g1[64 * j]; orow[64 * j] = v[j]; s2 += (v[j].x * v[j].x + v[j].y * v[j].y) + (v[j].z * v[j].z + v[j].w * v[j].w); }
        const float rstd2 = 1.0f / sqrtf(wave_sum(s2) * (1.f / D) + EPS);
        GAS unsigned long long* o8 = (GAS unsigned long long*)(F.XN + (size_t)m * D) + F.lane;
#pragma unroll
        for (int j = 0; j < 4; ++j) { const f32x4 y = v[j] * rstd2 * g2[64 * j]; o8[64 * j] = (unsigned long long)pk2(y.x, y.y) | ((unsigned long long)pk2(y.z, y.w) << 32); }
    }
}
__device__ __forceinline__ void p5b_rows(Frame& F) {
    const int gw = F.vcu * NWAVES + F.wave, NGW = F.G * NWAVES;
    for (int m = gw; m < M; m += NGW) {
        const GAS f32x4* tr = (const GAS f32x4*)(F.TMP + (size_t)m * D) + F.lane; GAS f32x4* orow = (GAS f32x4*)(F.out + (size_t)m * D) + F.lane;
        const GAS f32x4* g1 = (const GAS f32x4*)F.post_ffn_g + F.lane;
        f32x4 v[4]; float s = 0.f;
#pragma unroll
        for (int j = 0; j < 4; ++j) { v[j] = tr[64 * j]; s += (v[j].x * v[j].x + v[j].y * v[j].y) + (v[j].z * v[j].z + v[j].w * v[j].w); }
        const float rstd = 1.0f / sqrtf(wave_sum(s) * (1.f / D) + EPS);
#pragma unroll
        for (int j = 0; j < 4; ++j) orow[64 * j] = orow[64 * j] + v[j] * rstd * g1[64 * j];
    }
}

constexpr int GLA_T0 = 8;
__global__ void __launch_bounds__(128) naive_gla(const bf16* __restrict__ proj, const float* __restrict__ g_gla, bf16* __restrict__ mixed,
                                                 const float* __restrict__ x, const float* __restrict__ w_in, const float* __restrict__ pre_mix_g) {
    const int bh = blockIdx.x, b = bh >> 2, h = bh & 3, col = threadIdx.x, lane = col & 63, wave = col >> 6;
    __shared__ float red[2][2];
    __shared__ float hrow[D];
    __shared__ float qk0[GLA_T0][128];
    for (int t = 0; t < GLA_T0; ++t) {
        const float* xr = x + ((size_t)b * SEQ + t) * D; float s = 0.f;
        for (int i = col; i < D; i += 128) { const float v = xr[i]; s += v * v; }
        s = wave_sum(s); if (lane == 0) red[0][wave] = s; __syncthreads();
        const float rstd = 1.0f / sqrtf((red[0][0] + red[0][1]) * (1.f / D) + EPS);
        for (int i = col; i < D; i += 128) hrow[i] = xr[i] * rstd * pre_mix_g[i];
        __syncthreads();
        const int wc = (col < 64) ? (h * 64 + col) : (256 + h * 64 + (col - 64));
        float acc = 0.f;
        for (int k = 0; k < D; ++k) acc += hrow[k] * w_in[(size_t)k * IN_COLS + wc];
        qk0[t][col] = (col < 64) ? acc * 0.125f : acc;
        __syncthreads();
    }
    float S[64];
#pragma unroll
    for (int d = 0; d < 64; ++d) S[d] = 0.f;
    const float g = g_gla[col];
    for (int t = 0; t < SEQ; ++t) {
        const size_t row = (size_t)b * SEQ + t; const bf16* pr = proj + row * NPROJ;
        const float v = bf2f(pr[PC_GV + h * 128 + col]), og = bf2f(pr[PC_GOG + h * 128 + col]);
        float o = 0.f;
        if (t < GLA_T0) {
#pragma unroll
            for (int d = 0; d < 64; ++d) { const float a = exp2f(bf2f(pr[PC_LA + h * 64 + d])); const float k = qk0[t][64 + d]; const float q = qk0[t][d];
                S[d] = a * S[d] + k * v; o += q * S[d]; }
        } else {
#pragma unroll
            for (int d = 0; d < 64; ++d) { const float a = exp2f(bf2f(pr[PC_LA + h * 64 + d])); const float k = bf2f(pr[PC_GK + h * 64 + d]); const float q = bf2f(pr[PC_GQ + h * 64 + d]);
                S[d] = a * S[d] + k * v; o += q * S[d]; }
        }
        const float ss = wave_sum(o * o);
        if (lane == 0) red[t & 1][wave] = ss;
        __syncthreads();
        const float tot = red[t & 1][0] + red[t & 1][1];
        const float rstd = 1.0f / sqrtf(tot * (1.f / 128.f) + EPS);
        const float y = o * rstd * g * (og / (1.0f + __expf(-og)));
        mixed[row * D + h * 128 + col] = (bf16)f2bf(y);
    }
}
__global__ void __launch_bounds__(256) naive_attn(const bf16* __restrict__ proj, const float* __restrict__ lq1, const float* __restrict__ lk1, const float* __restrict__ lq2, const float* __restrict__ lk2,
                                                  const float* __restrict__ rel_bias, const float* __restrict__ g_diff, bf16* __restrict__ mixed) {
    __shared__ float Qs[32][129];
    __shared__ float Ks[32][129];
    __shared__ float Vs[32][128];
    __shared__ float As[32][33];
    __shared__ float lut[128];
    const int qt = blockIdx.x, bh = blockIdx.y, b = bh >> 2, h = bh & 3, tid = threadIdx.x, row = tid >> 3, sub = tid & 7;
    const int q0 = qt * 32;
    float s1 = 0.f, s2 = 0.f;
    for (int i = 0; i < 64; ++i) { s1 += lq1[i] * lk1[i]; s2 += lq2[i] * lk2[i]; }
    const float lam = expf(s1) - expf(s2) + LAMBDA_INIT;
    if (tid < 128) { const int n = tid; int bucket = n; if (n >= 16) { bucket = 16 + (int)(logf((float)n / 16.0f) / logf(8.0f) * 16.0f); bucket = bucket > 31 ? 31 : bucket; } lut[tid] = rel_bias[bucket * 4 + h] * LOG2E; }
    const float bias_far = rel_bias[31 * 4 + h] * LOG2E;
    const size_t rb = (size_t)b * SEQ;
    for (int i = 0; i < 16; ++i) { const int idx = tid + 256 * i, r = idx >> 7, c = idx & 127; Qs[r][c] = bf2f(proj[(rb + q0 + r) * NPROJ + PC_DQ + h * 128 + c]); }
    __syncthreads();
    const int qpos = q0 + row, nkt = qt + 1;
    float m1 = -INFINITY, l1 = 0.f, m2 = -INFINITY, l2 = 0.f;
    for (int kt = 0; kt < nkt; ++kt) {
        __syncthreads();
        for (int i = 0; i < 16; ++i) { const int idx = tid + 256 * i, r = idx >> 7, c = idx & 127; Ks[r][c] = bf2f(proj[(rb + kt * 32 + r) * NPROJ + PC_DK + h * 128 + c]); }
        __syncthreads();
        for (int j = 0; j < 4; ++j) { const int key = sub * 4 + j, kpos = kt * 32 + key; float a1 = 0.f, a2 = 0.f;
            for (int d = 0; d < 64; ++d) { a1 += Qs[row][d] * Ks[key][d]; a2 += Qs[row][64 + d] * Ks[key][64 + d]; }
            const int rel = qpos - kpos;
            if (rel >= 0) { const float bias = rel < 128 ? lut[rel] : bias_far; a1 += bias; a2 += bias;
                float mn = fmaxf(m1, a1); l1 = l1 * exp2f(m1 - mn) + exp2f(a1 - mn); m1 = mn;
                mn = fmaxf(m2, a2); l2 = l2 * exp2f(m2 - mn) + exp2f(a2 - mn); m2 = mn; } }
    }
#pragma unroll
    for (int o = 1; o < 8; o <<= 1) {
        const float om1 = __shfl_xor(m1, o), ol1 = __shfl_xor(l1, o), om2 = __shfl_xor(m2, o), ol2 = __shfl_xor(l2, o);
        float mn = fmaxf(m1, om1); l1 = (m1 == -INFINITY ? 0.f : l1 * exp2f(m1 - mn)) + (om1 == -INFINITY ? 0.f : ol1 * exp2f(om1 - mn)); m1 = mn;
        mn = fmaxf(m2, om2); l2 = (m2 == -INFINITY ? 0.f : l2 * exp2f(m2 - mn)) + (om2 == -INFINITY ? 0.f : ol2 * exp2f(om2 - mn)); m2 = mn;
    }
    const float il1 = 1.0f / l1, il2 = lam / l2;
    float o[16];
#pragma unroll
    for (int c = 0; c < 16; ++c) o[c] = 0.f;
    for (int kt = 0; kt < nkt; ++kt) {
        __syncthreads();
        for (int i = 0; i < 16; ++i) { const int idx = tid + 256 * i, r = idx >> 7, c = idx & 127; const size_t base = (rb + kt * 32 + r) * NPROJ;
            Ks[r][c] = bf2f(proj[base + PC_DK + h * 128 + c]); Vs[r][c] = bf2f(proj[base + PC_DV + h * 128 + c]); }
        __syncthreads();
        for (int j = 0; j < 4; ++j) { const int key = sub * 4 + j, kpos = kt * 32 + key; float a1 = 0.f, a2 = 0.f;
            for (int d = 0; d < 64; ++d) { a1 += Qs[row][d] * Ks[key][d]; a2 += Qs[row][64 + d] * Ks[key][64 + d]; }
            const int rel = qpos - kpos; float a = 0.f;
            if (rel >= 0) { const float bias = rel < 128 ? lut[rel] : bias_far; a = exp2f(a1 + bias - m1) * il1 - exp2f(a2 + bias - m2) * il2; }
            As[row][key] = a; }
        __syncthreads();
        for (int key = 0; key < 32; ++key) { const float a = As[row][key];
#pragma unroll
            for (int c = 0; c < 16; ++c) o[c] += a * Vs[key][sub * 16 + c]; }
    }
    float ss = 0.f;
#pragma unroll
    for (int c = 0; c < 16; ++c) ss += o[c] * o[c];
#pragma unroll
    for (int of = 1; of < 8; of <<= 1) ss += __shfl_xor(ss, of);
    const float rstd = 1.0f / sqrtf(ss * (1.f / 128.f) + EPS) * (1.0f - LAMBDA_INIT);
    bf16* orow = mixed + (rb + qpos) * D + 512 + h * 128 + sub * 16;
#pragma unroll
    for (int c = 0; c < 16; ++c) orow[c] = (bf16)f2bf(o[c] * rstd * g_diff[sub * 16 + c]);
}

struct Args { const float* in[19]; float* out; unsigned char* ws; int ph_lo, ph_hi; };
__global__ void __launch_bounds__(NWAVES * 64, 2) skel_fwd(Args args) {
    extern __shared__ __attribute__((aligned(16))) unsigned char lds[];
    Frame F;
    F.lds = (LAS unsigned char*)lds;
    F.tid = threadIdx.x; F.lane = F.tid & 63; F.wave = __builtin_amdgcn_readfirstlane(F.tid >> 6);
    F.G = gridDim.x; { const int bx = blockIdx.x; F.vcu = (F.G % 8 == 0) ? (bx % 8) * (F.G / 8) + bx / 8 : bx; }
    unsigned char* ws = args.ws;
    F.x = args.in[0]; F.w_in = args.in[1]; F.w_gk_up = args.in[2]; F.b_gk = args.in[3]; F.lq1 = args.in[4]; F.lk1 = args.in[5]; F.lq2 = args.in[6]; F.lk2 = args.in[7];
    F.rel_bias = args.in[8]; F.g_gla = args.in[9]; F.g_diff = args.in[10]; F.w_out = args.in[11]; F.pre_mix_g = args.in[12]; F.post_mix_g = args.in[13];
    F.w_gate = args.in[14]; F.w_up = args.in[15]; F.w_down = args.in[16]; F.pre_ffn_g = args.in[17]; F.post_ffn_g = args.in[18]; F.out = args.out;
    F.Win_t = (bf16*)(ws + WS_WIN); F.Wout_t = (bf16*)(ws + WS_WOUT); F.Wgu_t = (bf16*)(ws + WS_WGU); F.Wdn_t = (bf16*)(ws + WS_WDN);
    F.PROJ = (bf16*)(ws + WS_PROJ); F.HID = (bf16*)(ws + WS_HID); F.XN = (bf16*)(ws + WS_XN); F.MIXED = (bf16*)(ws + WS_MIXED); F.TMP = (float*)(ws + WS_TMP);
    const int lo = args.ph_lo, hi = args.ph_hi;
#define IN(k) (lo <= (k) && (k) < hi)
    if (IN(0)) { p0_prologue(F); }
    if (IN(1)) {
        pg8::Gemm g{F.XN, F.Win_t, M, NPROJ, D}; pg8::StaticOrder S; S.init(M, NPROJ, F.G, (int)blockIdx.x);
        pg8::EpiProj E{F.PROJ, NPROJ, F.b_gk};
        pg8::gemm_phase<pg8::EpiProj, pg8::StaticOrder, true, true>(F.lds, g, S, E);
    }
    if (IN(3)) {
        pg8::Gemm g{F.MIXED, F.Wout_t, M, D, D}; pg8::StaticOrder S; S.init(M, D, F.G, (int)blockIdx.x);
        pg8::EpiF32 E{F.TMP, D};
        pg8::gemm_phase<pg8::EpiF32, pg8::StaticOrder, true, true>(F.lds, g, S, E);
    }
    if (IN(4)) { p3b_rows(F); }
    if (IN(5)) {
        pg8::Gemm g{F.XN, F.Wgu_t, M, NGU, D}; pg8::StaticOrder S; S.init(M, NGU, F.G, (int)blockIdx.x);
        pg8::EpiSwiGLU E{F.HID, FF};
        pg8::gemm_phase<pg8::EpiSwiGLU, pg8::StaticOrder, true, true>(F.lds, g, S, E);
    }
    if (IN(6)) {
        pg8::Gemm g{F.HID, F.Wdn_t, M, D, FF}; pg8::StaticOrder S; S.init(M, D, F.G, (int)blockIdx.x);
        pg8::EpiF32 E{F.TMP, D};
        pg8::gemm_phase<pg8::EpiF32, pg8::StaticOrder, true, true>(F.lds, g, S, E);
    }
    if (IN(7)) { p5b_rows(F); }
#undef IN
}

extern "C" void kernel_launch(void* const* d_in, const int* in_sizes, int n_in, void* d_out, int out_size, void* d_ws, size_t ws_size, hipStream_t stream) {
    static int grid = 0;
    if (grid == 0) {
        if (n_in != 19 || in_sizes[0] != M * D || out_size != M * D || ws_size < WS_END) { fprintf(stderr, "kernel_launch: unexpected shapes: n_in %d in0 %d out %d ws %zu\n", n_in, n_in > 0 ? in_sizes[0] : -1, out_size, ws_size); grid = -1; return; }
        int dev = 0, cus = 0;
        if (hipGetDevice(&dev) != hipSuccess || hipDeviceGetAttribute(&cus, hipDeviceAttributeMultiprocessorCount, dev) != hipSuccess) { grid = -1; return; }
        if (hipFuncSetAttribute((const void*)skel_fwd, hipFuncAttributeMaxDynamicSharedMemorySize, LDS_BYTES) != hipSuccess) { fprintf(stderr, "kernel_launch: hipFuncSetAttribute failed\n"); grid = -1; return; }
        grid = cus;
    }
    if (grid < 0) return;
    Args a{};
    for (int i = 0; i < 19; ++i) a.in[i] = (const float*)d_in[i];
    a.out = (float*)d_out; a.ws = (unsigned char*)d_ws;
    auto launch = [&](int lo, int hi) { a.ph_lo = lo; a.ph_hi = hi; hipLaunchKernelGGL(skel_fwd, dim3(grid), dim3(NWAVES * 64), LDS_BYTES, stream, a); };
    launch(0, 1);
    launch(1, 2);
    const bf16* proj = (const bf16*)((unsigned char*)d_ws + WS_PROJ); bf16* mixed = (bf16*)((unsigned char*)d_ws + WS_MIXED);
    hipLaunchKernelGGL(naive_gla, dim3(BATCH * 4), dim3(128), 0, stream, proj, (const float*)d_in[9], mixed, (const float*)d_in[0], (const float*)d_in[1], (const float*)d_in[12]);
    hipLaunchKernelGGL(naive_attn, dim3(SEQ / 32, BATCH * 4), dim3(256), 0, stream, proj, (const float*)d_in[4], (const float*)d_in[5], (const float*)d_in[6], (const float*)d_in[7], (const float*)d_in[8], (const float*)d_in[10], mixed);
    launch(3, 4);
    launch(4, 5);
    launch(5, 6);
    launch(6, 7);
    launch(7, 8);
}
```

```cpp
#include <hip/hip_runtime.h>
#include <cstdio>
#include <cstdint>
namespace pg8 {
#define PG8_LAS __attribute__((address_space(3)))
typedef unsigned short bf16_t;
typedef short bf16x8 __attribute__((ext_vector_type(8)));
typedef float f32x4 __attribute__((ext_vector_type(4)));
typedef unsigned u32x4 __attribute__((ext_vector_type(4)));
constexpr int BM = 256, BK = 64, HALF = 128, HTB = HALF * BK * 2  , STAGE_BYTES = 8 * HTB, NXCD = 8, WGM = 8;

__host__ __device__ __forceinline__ int lds_byte(int r, int c) { const int st = (r >> 4) * 2 + (c >> 5), rr = r & 15, cc = c & 31, ob = rr * 64 + cc * 2; return st * 1024 + (ob ^ (((ob >> 9) & 1) << 5)); }
__host__ __device__ __forceinline__ void stage_rc(int b, int& R, int& C) { const int st = b / 1024, sb = b % 1024, swz = sb ^ (((sb >> 9) & 1) << 5); R = (st >> 1) * 16 + swz / 64; C = (st & 1) * 32 + (swz % 64) / 2; }
__host__ __device__ __forceinline__ int perm32(int rho) { const int n = rho >> 4, i = rho & 15; return 8 * (i >> 2) + 4 * n + (i & 3); }

struct Unit { int pm, pn; };
struct Gemm { const bf16_t* A; const bf16_t* Bt; int M, N, K; };

struct StaticOrder {
    int nM, nN, nwg, G, c;
    __host__ __device__ void init(int M, int N, int G_, int c_) { nM = M / BM; nN = N / BM; nwg = nM * nN; G = G_; c = c_; }
    __host__ __device__ bool next(int i, Unit& u) const {
        const long L = (long)i * G + c; if (L >= nwg) return false;
        int wgid = (int)L; { const int q = nwg / NXCD, r = nwg % NXCD, xcd = wgid % NXCD, off = wgid / NXCD; wgid = (xcd < r ? xcd * (q + 1) : r * (q + 1) + (xcd - r) * q) + off; }
        const int nig = WGM * nN, gid = wgid / nig, fm = gid * WGM, gsz = (nM - fm) < WGM ? (nM - fm) : WGM;
        u.pm = fm + ((wgid % nig) % gsz); u.pn = (wgid % nig) / gsz; return true;
    }
    __device__ __forceinline__ void a_ready(const Unit&) const {}
    __device__ __forceinline__ void done(const Unit&) const {}
};

__device__ __forceinline__ unsigned cvt_pk_bf16(float lo, float hi) { unsigned r; asm volatile("v_cvt_pk_bf16_f32 %0, %1, %2" : "=v"(r) : "v"(lo), "v"(hi)); return r; }
constexpr float LOG2E_F = 1.4426950408889634f;

struct EpiF32 {
    static constexpr bool PERM = false, AFTER_DRAIN = false;
    float* C; int ldc;
    __device__ __forceinline__ void operator()(const f32x4 (&acc)[2][2][4][2], const Unit& u, int wr, int wc, int fr, int fq) const {
        const int row0 = u.pm * BM + wr * 64 + fr, col0 = u.pn * BM + wc * 32 + 4 * fq;
#pragma unroll
        for (int ai = 0; ai < 2; ++ai)
#pragma unroll
            for (int m = 0; m < 4; ++m) { float* rowp = C + (size_t)(row0 + ai * HALF + m * 16) * ldc + col0;
#pragma unroll
                for (int bj = 0; bj < 2; ++bj)
#pragma unroll
                    for (int n = 0; n < 2; ++n) *(f32x4*)(rowp + bj * HALF + n * 16) = acc[ai][bj][m][n]; }
    }
};

struct EpiProj {
    static constexpr bool PERM = true, AFTER_DRAIN = false;
    bf16_t* O; int ldc; const float* b_gk;
    __device__ __forceinline__ void operator()(const f32x4 (&acc)[2][2][4][2], const Unit& u, int wr, int wc, int fr, int fq) const {
        const int row0 = u.pm * BM + wr * 64 + fr; const int col0 = u.pn * BM + wc * 32 + 8 * fq;
        const float sc = (u.pn == 0) ? 0.125f : ((u.pn == 6 || u.pn == 7) ? 0.125f * LOG2E_F : 1.0f);
        const bool gate = (u.pn == 12);
        f32x4 bv[2][2];
#pragma unroll
        for (int bj = 0; bj < 2; ++bj)
#pragma unroll
            for (int n = 0; n < 2; ++n) bv[bj][n] = gate ? *(const f32x4*)(b_gk + (col0 - 3072) + bj * HALF + 4 * n) : (f32x4){0.f, 0.f, 0.f, 0.f};
#pragma unroll
        for (int ai = 0; ai < 2; ++ai)
#pragma unroll
            for (int m = 0; m < 4; ++m) { bf16_t* rowp = O + (size_t)(row0 + ai * HALF + m * 16) * ldc + col0;
#pragma unroll
                for (int bj = 0; bj < 2; ++bj) { f32x4 v0 = acc[ai][bj][m][0], v1 = acc[ai][bj][m][1];
                    if (gate) {
                        v0 += bv[bj][0]; v1 += bv[bj][1];
#pragma unroll
                        for (int e = 0; e < 4; ++e) {
                            { const float z = v0[e]; const float t = __expf(-fabsf(z)); v0[e] = (fminf(z, 0.f) - __logf(1.0f + t)) * (LOG2E_F / 16.0f); }
                            { const float z = v1[e]; const float t = __expf(-fabsf(z)); v1[e] = (fminf(z, 0.f) - __logf(1.0f + t)) * (LOG2E_F / 16.0f); }
                        }
                    } else { v0 = v0 * sc; v1 = v1 * sc; }
                    u32x4 w; w.x = cvt_pk_bf16(v0[0], v0[1]); w.y = cvt_pk_bf16(v0[2], v0[3]); w.z = cvt_pk_bf16(v1[0], v1[1]); w.w = cvt_pk_bf16(v1[2], v1[3]);
                    *(u32x4*)(rowp + bj * HALF) = w; } }
    }
};

struct EpiSwiGLU {
    static constexpr bool PERM = true, AFTER_DRAIN = false;
    bf16_t* H; int ldc;
    __device__ __forceinline__ void operator()(const f32x4 (&acc)[2][2][4][2], const Unit& u, int wr, int wc, int fr, int fq) const {
        const int row0 = u.pm * BM + wr * 64 + fr; const int col0 = u.pn * HALF + wc * 32 + 8 * fq;
#pragma unroll
        for (int ai = 0; ai < 2; ++ai)
#pragma unroll
            for (int m = 0; m < 4; ++m) { bf16_t* rowp = H + (size_t)(row0 + ai * HALF + m * 16) * ldc + col0;
                f32x4 h0, h1;
#pragma unroll
                for (int e = 0; e < 4; ++e) {
                    { const float g = acc[ai][0][m][0][e], up = acc[ai][1][m][0][e]; h0[e] = g * __builtin_amdgcn_rcpf(1.0f + __builtin_amdgcn_exp2f(-g * LOG2E_F)) * up; }
                    { const float g = acc[ai][0][m][1][e], up = acc[ai][1][m][1][e]; h1[e] = g * __builtin_amdgcn_rcpf(1.0f + __builtin_amdgcn_exp2f(-g * LOG2E_F)) * up; }
                }
                u32x4 w; w.x = cvt_pk_bf16(h0[0], h0[1]); w.y = cvt_pk_bf16(h0[2], h0[3]); w.z = cvt_pk_bf16(h1[0], h1[1]); w.w = cvt_pk_bf16(h1[2], h1[3]);
                *(u32x4*)rowp = w; }
    }
};
template <class Epi, class Sched, bool ALIGN_EPI = false, bool SP2 = false>
__device__ __forceinline__ void gemm_phase(PG8_LAS unsigned char* lds, const Gemm g, const Sched& S, const Epi& E) {
    const int tid = threadIdx.x, wid = __builtin_amdgcn_readfirstlane(tid >> 6), lane = tid & 63, wr = wid >> 2, wc = wid & 3, fr = lane & 15, fq = lane >> 4;
    const int K = g.K, nt = K / BK;
    unsigned voffA[2], voffB[2];
#pragma unroll
    for (int i = 0; i < 2; ++i) { int R, C; stage_rc(tid * 16 + i * 8192, R, C); const int Rb = Epi::PERM ? ((R & ~31) + perm32(R & 31)) : R;
        voffA[i] = (unsigned)(R * K + C) * 2u; voffB[i] = (unsigned)(Rb * K + C) * 2u; }
    const size_t kstep = (size_t)(BK * 2);
    const size_t hstep = (size_t)HALF * K * 2;
    const size_t tstep = 2 * hstep;
    const unsigned ldsw = (unsigned)wid * 1024u;
    const int aoff = lds_byte(wr * 64 + fr, fq * 8), boff = lds_byte(wc * 32 + fr, fq * 8);
#define PG8_SA(b, h) (((b) * 2 + (h)) * HTB)
#define PG8_SB(b, h) ((4 + (b) * 2 + (h)) * HTB)
#define PG8_STAGE(bufoff, gbase, voff) do { _Pragma("unroll") for (int _i = 0; _i < 2; ++_i) \
        __builtin_amdgcn_global_load_lds((const unsigned*)((const char*)(gbase) + (voff)[_i]), (PG8_LAS unsigned*)(lds + (bufoff) + ldsw + _i * 8192), 16, 0, 0); } while (0)
#define PG8_LDA(dst, b, h) do { _Pragma("unroll") for (int m = 0; m < 4; ++m) _Pragma("unroll") for (int k = 0; k < 2; ++k) dst[m][k] = *(const PG8_LAS bf16x8*)(lds + PG8_SA(b, h) + aoff + m * 2048 + k * 1024); } while (0)
#define PG8_LDB(dst, b, h) do { _Pragma("unroll") for (int n = 0; n < 2; ++n) _Pragma("unroll") for (int k = 0; k < 2; ++k) dst[n][k] = *(const PG8_LAS bf16x8*)(lds + PG8_SB(b, h) + boff + n * 2048 + k * 1024); } while (0)
#define PG8_MMA(ai, bj, At, Bt) do { __builtin_amdgcn_s_setprio(1); _Pragma("unroll") for (int m = 0; m < 4; ++m) _Pragma("unroll") for (int n = 0; n < 2; ++n) _Pragma("unroll") for (int k = 0; k < 2; ++k) \
        acc[ai][bj][m][n] = __builtin_amdgcn_mfma_f32_16x16x32_bf16(Bt[n][k], At[m][k], acc[ai][bj][m][n], 0, 0, 0); __builtin_amdgcn_s_setprio(0); } while (0)
#define PG8_WAIT_V(n) asm volatile("s_waitcnt vmcnt(" #n ")" ::: "memory")
#define PG8_WAIT_L(n) asm volatile("s_waitcnt lgkmcnt(" #n ")" ::: "memory")
#define PG8_BAR __builtin_amdgcn_s_barrier()
#define PG8_SCHED __builtin_amdgcn_sched_barrier(0)
    Unit cur, nxt; int ui = 0;
    if (!S.next(0, cur)) return;
    f32x4 acc[2][2][4][2];
#pragma unroll
    for (int a = 0; a < 2; ++a)
#pragma unroll
        for (int b = 0; b < 2; ++b)
#pragma unroll
            for (int m = 0; m < 4; ++m)
#pragma unroll
                for (int n = 0; n < 2; ++n) acc[a][b][m][n] = (f32x4){0.f, 0.f, 0.f, 0.f};
    bf16x8 At[4][2], B0[2][2], B1[2][2];
    const char* cA = (const char*)g.A + (size_t)cur.pm * tstep; const char* cB = (const char*)g.Bt + (size_t)cur.pn * tstep;
    S.a_ready(cur);
    if constexpr (SP2) {
        PG8_STAGE(PG8_SB(0, 0), cB, voffB); PG8_STAGE(PG8_SB(0, 1), cB + hstep, voffB); PG8_STAGE(PG8_SA(0, 0), cA, voffA); PG8_STAGE(PG8_SA(0, 1), cA + hstep, voffA);
        if (wr == 1) PG8_BAR;
        PG8_WAIT_V(2); PG8_BAR;
        PG8_STAGE(PG8_SB(1, 0), cB + kstep, voffB); PG8_STAGE(PG8_SA(1, 0), cA + kstep, voffA); PG8_STAGE(PG8_SB(1, 1), cB + hstep + kstep, voffB);
        PG8_WAIT_V(6); PG8_BAR;
    } else {
        PG8_STAGE(PG8_SB(0, 0), cB, voffB); PG8_STAGE(PG8_SA(0, 0), cA, voffA); PG8_STAGE(PG8_SB(0, 1), cB + hstep, voffB); PG8_STAGE(PG8_SA(0, 1), cA + hstep, voffA);
        if (wr == 1) PG8_BAR;
        PG8_WAIT_V(4); PG8_BAR;
        PG8_STAGE(PG8_SB(1, 0), cB + kstep, voffB); PG8_STAGE(PG8_SA(1, 0), cA + kstep, voffA); PG8_STAGE(PG8_SB(1, 1), cB + hstep + kstep, voffB);
        PG8_WAIT_V(6); PG8_BAR;
    }
    for (;;) {
        const bool has_next = S.next(ui + 1, nxt);
        const char* nA = has_next ? (const char*)g.A + (size_t)nxt.pm * tstep : cA; const char* nB = has_next ? (const char*)g.Bt + (size_t)nxt.pn * tstep : cB;
        for (int t = 0; t < nt; t += 2) {
            const bool last = (t == nt - 2);
            const char* a1 = cA + (size_t)(t + 1) * kstep;
            const char* a2 = last ? nA : cA + (size_t)(t + 2) * kstep; const char* b2 = last ? nB : cB + (size_t)(t + 2) * kstep;
            const char* a3 = a2 + kstep; const char* b3 = b2 + kstep;
            if (last && has_next) S.a_ready(nxt);
            if constexpr (SP2) {
            PG8_LDB(B0, 0, 0); PG8_LDB(B1, 0, 1); PG8_SCHED; PG8_LDA(At, 0, 0); PG8_STAGE(PG8_SA(1, 1), a1 + hstep, voffA);
            PG8_WAIT_V(8); PG8_WAIT_L(0); PG8_BAR; PG8_MMA(0, 0, At, B0); PG8_MMA(0, 1, At, B1); PG8_BAR; PG8_SCHED;
            PG8_LDA(At, 0, 1); PG8_STAGE(PG8_SB(0, 0), b2, voffB); PG8_STAGE(PG8_SB(0, 1), b2 + hstep, voffB); PG8_STAGE(PG8_SA(0, 0), a2, voffA);
            PG8_WAIT_V(8); PG8_WAIT_L(0); PG8_BAR; PG8_MMA(1, 0, At, B0); PG8_MMA(1, 1, At, B1); PG8_BAR; PG8_SCHED;
            PG8_LDB(B0, 1, 0); PG8_LDB(B1, 1, 1); PG8_SCHED; PG8_LDA(At, 1, 0); PG8_STAGE(PG8_SA(0, 1), a2 + hstep, voffA);
            PG8_WAIT_V(8); PG8_WAIT_L(0); PG8_BAR; PG8_MMA(0, 0, At, B0); PG8_MMA(0, 1, At, B1); PG8_BAR; PG8_SCHED;
            PG8_LDA(At, 1, 1); PG8_STAGE(PG8_SB(1, 0), b3, voffB); PG8_STAGE(PG8_SB(1, 1), b3 + hstep, voffB); PG8_STAGE(PG8_SA(1, 0), a3, voffA);
            PG8_WAIT_V(8); PG8_WAIT_L(0); PG8_BAR; PG8_MMA(1, 0, At, B0); PG8_MMA(1, 1, At, B1); PG8_BAR; PG8_SCHED;
            } else {
            PG8_LDB(B0, 0, 0); PG8_SCHED; PG8_LDA(At, 0, 0); PG8_STAGE(PG8_SA(1, 1), a1 + hstep, voffA);
            PG8_WAIT_L(8); PG8_BAR; PG8_WAIT_L(0); PG8_MMA(0, 0, At, B0); PG8_BAR; PG8_SCHED;
            PG8_LDB(B1, 0, 1); PG8_STAGE(PG8_SB(0, 0), b2, voffB);
            PG8_BAR; PG8_WAIT_L(0); PG8_MMA(0, 1, At, B1); PG8_BAR;
            PG8_LDA(At, 0, 1); PG8_STAGE(PG8_SA(0, 0), a2, voffA);
            PG8_BAR; PG8_WAIT_L(0); PG8_MMA(1, 0, At, B0); PG8_BAR; PG8_SCHED;
            PG8_STAGE(PG8_SB(0, 1), b2 + hstep, voffB);
            PG8_WAIT_V(6); PG8_BAR; PG8_MMA(1, 1, At, B1); PG8_BAR;
            PG8_LDB(B0, 1, 0); PG8_SCHED; PG8_LDA(At, 1, 0); PG8_STAGE(PG8_SA(0, 1), a2 + hstep, voffA);
            PG8_WAIT_L(8); PG8_BAR; PG8_WAIT_L(0); PG8_MMA(0, 0, At, B0); PG8_BAR; PG8_SCHED;
            PG8_LDB(B1, 1, 1); PG8_STAGE(PG8_SB(1, 0), b3, voffB);
            PG8_BAR; PG8_WAIT_L(0); PG8_MMA(0, 1, At, B1); PG8_BAR;
            PG8_LDA(At, 1, 1); PG8_STAGE(PG8_SA(1, 0), a3, voffA);
            PG8_BAR; PG8_WAIT_L(0); PG8_MMA(1, 0, At, B0); PG8_BAR; PG8_SCHED;
            PG8_STAGE(PG8_SB(1, 1), b3 + hstep, voffB);
            PG8_WAIT_V(6); PG8_BAR; PG8_MMA(1, 1, At, B1); PG8_BAR;
            }
        }
        if constexpr (ALIGN_EPI) { if (wr == 0) PG8_BAR; }
        if constexpr (!Epi::AFTER_DRAIN) { E(acc, cur, wr, wc, fr, fq); S.done(cur); }
        if (!has_next) break;
#pragma unroll
        for (int a = 0; a < 2; ++a)
#pragma unroll
            for (int b = 0; b < 2; ++b)
#pragma unroll
                for (int m = 0; m < 4; ++m)
#pragma unroll
                    for (int n = 0; n < 2; ++n) acc[a][b][m][n] = (f32x4){0.f, 0.f, 0.f, 0.f};
        cur = nxt; cA = nA; cB = nB; ++ui;
        if constexpr (ALIGN_EPI) { if (wr == 1) PG8_BAR; }
    }
    PG8_WAIT_V(0);
    if constexpr (!ALIGN_EPI) { if (wr == 0) PG8_BAR; }
    PG8_BAR;
    if constexpr (Epi::AFTER_DRAIN) { E.fused(acc, cur, wr, wc, fr, fq, lds, wid, lane); S.done(cur); }
#undef PG8_SA
#undef PG8_SB
#undef PG8_STAGE
#undef PG8_LDA
#undef PG8_LDB
#undef PG8_MMA
#undef PG8_WAIT_V
#undef PG8_WAIT_L
#undef PG8_BAR
#undef PG8_SCHED
}
}

constexpr int NWAVES = 8;
constexpr int BATCH = 32, SEQ = 2048, D = 1024, M = BATCH * SEQ;
constexpr int NPROJ = 3328;
constexpr int PC_GQ = 0, PC_GK = 256, PC_GV = 512, PC_GOG = 1024, PC_DQ = 1536, PC_DK = 2048, PC_DV = 2560, PC_LA = 3072;
constexpr int IN_COLS = 3088, GLOW_COL = 1536, GATE_RANK = 16;
constexpr int FF = 2816, NGU = 2 * FF;
constexpr float EPS = 1e-6f, LOG2E = 1.4426950408889634f;
constexpr float LAMBDA_INIT = 0.2f;
constexpr int GLA_T0 = 8;

constexpr size_t MiB = 1u << 20;
constexpr size_t WS_CTL = 0, CTL_ZERO_BYTES = 1 * MiB;
constexpr size_t WS_WIN = 2 * MiB;
constexpr size_t WS_WOUT = 9 * MiB;
constexpr size_t WS_WGU = 11 * MiB;
constexpr size_t WS_WDN = 22 * MiB;
constexpr size_t WS_XCH = 28 * MiB;
constexpr size_t WS_PROJ = 64 * MiB;
constexpr size_t WS_HID = WS_PROJ;
constexpr size_t WS_XN = 480 * MiB;
constexpr size_t WS_MIXED = 608 * MiB;
constexpr size_t WS_TMP = 736 * MiB;
constexpr size_t WS_END = 992 * MiB;

constexpr int LDS_BYTES = 147456;

#define GAS __attribute__((address_space(1)))
#define LAS __attribute__((address_space(3)))
typedef unsigned short bf16;
typedef unsigned v4u __attribute__((ext_vector_type(4)));
typedef float f32x4 __attribute__((ext_vector_type(4)));
#define LDS_WAIT() asm volatile("s_waitcnt lgkmcnt(0)" ::: "memory")
__device__ __forceinline__ unsigned f2bf(float f) { unsigned u = __builtin_bit_cast(unsigned, f); return (u + 0x7fffu + ((u >> 16) & 1u)) >> 16; }
__device__ __forceinline__ unsigned pk2(float lo, float hi) { return f2bf(lo) | (f2bf(hi) << 16); }
__device__ __forceinline__ float bf2f(bf16 v) { return __builtin_bit_cast(float, (unsigned)v << 16); }
__device__ __forceinline__ float wave_sum(float v) {
#pragma unroll
    for (int o = 1; o < 64; o <<= 1) v += __shfl_xor(v, o);
    return v;
}


typedef GAS unsigned gu32;
typedef GAS unsigned long long gu64;
#define RLX_AGENT __ATOMIC_RELAXED, __HIP_MEMORY_SCOPE_AGENT
#define VM_WAIT() asm volatile("s_waitcnt vmcnt(0)" ::: "memory")
constexpr int RING_BYTES = 131072, LDSCTL_OFF = RING_BYTES, MISC_OFF = LDSCTL_OFF + 320;
constexpr int CW_TMO = 0, CW_CODE = 1, CW_BAR = 4096, CW_SEAM = 16384;
#define XB_TMO      128
#define XB_XCNT(j)  (256  + 64 * (j))
#define XB_XSUB(j)  (1280 + 64 * (j))
#define XB_XGEN(j)  (2304 + 64 * (j))
#define XB_TOP      3328
#define XB_TOPGEN   3392
#define XCD_BAR_WORDS 3456
#define XB_SPIN_CAP (1u << 18)

__device__ __forceinline__ unsigned xb_ld(unsigned* p)              { return __hip_atomic_load(p, __ATOMIC_RELAXED, __HIP_MEMORY_SCOPE_AGENT); }
__device__ __forceinline__ unsigned xb_add(unsigned* p, unsigned v) { return __hip_atomic_fetch_add(p, v, __ATOMIC_RELAXED, __HIP_MEMORY_SCOPE_AGENT); }
__device__ __forceinline__ unsigned xb_xcc_id() { return (unsigned)__builtin_amdgcn_s_getreg((3 << 11) | 20) & 0xFu; }
#define XB_SPIN(cond, bar) do { unsigned _sp = 0; while (cond) { __builtin_amdgcn_s_sleep(1); \
    if ((++_sp & 255u) == 0u) { if (xb_ld(&(bar)[XB_TMO])) break; if (_sp > XB_SPIN_CAP) { atomicAdd(&(bar)[XB_TMO], 1u); break; } } } } while (0)

struct XcdBarrier {
    unsigned* bar; unsigned x;
    volatile LAS unsigned* st;
};

__device__ __forceinline__ XcdBarrier xcd_barrier_post(unsigned* bar, volatile LAS unsigned* st) {
    XcdBarrier b; b.bar = bar; b.x = xb_xcc_id(); b.st = st;
    if (threadIdx.x == 0) (void)xb_add(&bar[XB_XCNT(b.x)], 1u);
    return b;
}
__device__ __forceinline__ void xcd_barrier_complete(unsigned* bar, unsigned x, unsigned& nloc, unsigned& nx) {
    const unsigned G = gridDim.x * gridDim.y * gridDim.z;
    unsigned sum, cnt, mine, sp = 0u;
    for (;;) {
        sum = 0u; cnt = 0u; mine = 0u;
#pragma unroll
        for (unsigned j = 0; j < 16; ++j) { const unsigned c = xb_ld(&bar[XB_XCNT(j)]); sum += c; cnt += (c > 0u) ? 1u : 0u; mine = (j == x) ? c : mine; }
        if (sum == G) break;
        __builtin_amdgcn_s_sleep(1);
        if ((++sp & 255u) == 0u) { if (xb_ld(&bar[XB_TMO])) break; if (sp > XB_SPIN_CAP) { atomicAdd(&bar[XB_TMO], 1u); break; } }
    }
    nloc = mine > 0u ? mine : 1u; nx = cnt > 0u ? cnt : 1u;
}

__device__ __forceinline__ void xcd_barrier(const XcdBarrier& b) {
    asm volatile("s_waitcnt vmcnt(0)" ::: "memory");
    __syncthreads();
    if (threadIdx.x == 0) {
        unsigned* bar = b.bar;
        __builtin_amdgcn_s_waitcnt(0);
        unsigned nloc = b.st[0], nx = b.st[1];
        if (nloc == 0u) { xcd_barrier_complete(bar, b.x, nloc, nx); b.st[0] = nloc; b.st[1] = nx; }
        const unsigned old = xb_add(&bar[XB_XSUB(b.x)], 1u);
        const unsigned gen = old / nloc;
        if (old + 1u == (gen + 1u) * nloc) {
            __builtin_amdgcn_fence(__ATOMIC_RELEASE, "agent");
            asm volatile("s_waitcnt vmcnt(0)" ::: "memory");
            const unsigned og = xb_add(&bar[XB_TOP], 1u);
            const unsigned tg = og / nx;
            if (og + 1u == (tg + 1u) * nx) xb_add(&bar[XB_TOPGEN], 1u);
            else XB_SPIN(xb_ld(&bar[XB_TOPGEN]) == tg, bar);
            __builtin_amdgcn_fence(__ATOMIC_ACQUIRE, "agent");
            xb_add(&bar[XB_XGEN(b.x)], 1u);
            asm volatile("s_waitcnt vmcnt(0)" ::: "memory");
        } else {
            XB_SPIN(xb_ld(&bar[XB_XGEN(b.x)]) == gen, bar);
            __builtin_amdgcn_fence(__ATOMIC_ACQUIRE, "agent");
            asm volatile("s_waitcnt vmcnt(0)" ::: "memory");
        }
    }
    __syncthreads();
}

struct Frame {
    LAS unsigned char* lds;
    int tid, lane, wave, vcu, G;
    volatile LAS unsigned* MISC; gu32* ctl;
    const float *x, *w_in, *w_gk_up, *b_gk, *lq1, *lk1, *lq2, *lk2, *rel_bias, *g_gla, *g_diff, *w_out, *pre_mix_g, *post_mix_g, *w_gate, *w_up, *w_down, *pre_ffn_g, *post_ffn_g;
    float* out;
    bf16 *Win_t, *Wout_t, *Wgu_t, *Wdn_t, *PROJ, *HID, *XN, *MIXED; float* TMP;
};

__device__ __forceinline__ void p0_transpose_item(const float* W, int K, int ldw, int src_col0, bf16* WT, int dst_row0, int kb, LAS float* scr, int lane) {
    const int k0 = 64 * kb;
#pragma unroll 8
    for (int i = 0; i < 32; ++i) { const int kk = 2 * i + (lane >> 5); scr[kk * 33 + (lane & 31)] = W[(size_t)(k0 + kk) * ldw + src_col0 + (lane & 31)]; }
    LDS_WAIT(); asm volatile("" ::: "memory");
    const int c = lane & 7;
#pragma unroll
    for (int j = 0; j < 4; ++j) { const int n = (lane >> 3) + 8 * j; const LAS float* s = scr + (8 * c) * 33 + n;
        v4u o; o.x = pk2(s[0 * 33], s[1 * 33]); o.y = pk2(s[2 * 33], s[3 * 33]); o.z = pk2(s[4 * 33], s[5 * 33]); o.w = pk2(s[6 * 33], s[7 * 33]);
        *(GAS v4u*)(WT + (size_t)(dst_row0 + n) * K + k0 + 8 * c) = o; }
    LDS_WAIT(); asm volatile("" ::: "memory");
}
__device__ __forceinline__ void rms_row_to_bf16(const float* xrow, const float* g, bf16* orow, int lane) {
    const GAS f32x4* xr = (const GAS f32x4*)xrow + lane; const GAS f32x4* gr = (const GAS f32x4*)g + lane;
    f32x4 v[4]; float s = 0.f;
#pragma unroll
    for (int j = 0; j < 4; ++j) { v[j] = xr[64 * j]; s += (v[j].x * v[j].x + v[j].y * v[j].y) + (v[j].z * v[j].z + v[j].w * v[j].w); }
    const float rstd = 1.0f / sqrtf(wave_sum(s) * (1.f / D) + EPS);
    GAS unsigned long long* o8 = (GAS unsigned long long*)orow + lane;
#pragma unroll
    for (int j = 0; j < 4; ++j) { const f32x4 gv = gr[64 * j]; const f32x4 y = v[j] * rstd * gv;
        o8[64 * j] = (unsigned long long)pk2(y.x, y.y) | ((unsigned long long)pk2(y.z, y.w) << 32); }
}
__device__ __forceinline__ void p0_prologue(Frame& F) {
    LAS float* scr = (LAS float*)(F.lds + F.wave * 16384);
    const int gw = F.vcu * NWAVES + F.wave, NGW = F.G * NWAVES;
    constexpr int KB_D = D / 64, KB_FF = FF / 64;
    constexpr int I_INA = KB_D * (1536 / 32), I_INB = I_INA, I_OUT = KB_D * (D / 32), I_G = KB_D * (FF / 32), I_U = I_G, I_DN = KB_FF * (D / 32);
    constexpr int NITEMS = I_INA + I_INB + I_OUT + I_G + I_U + I_DN;
    for (int it = gw; it < NITEMS; it += NGW) {
        int r = it;
        if (r < I_INA) { const int kb = r / 48, nb = r % 48; p0_transpose_item(F.w_in, D, IN_COLS, 32 * nb, F.Win_t, 32 * nb, kb, scr, F.lane); continue; } r -= I_INA;
        if (r < I_INB) { const int kb = r / 48, nb = r % 48; p0_transpose_item(F.w_in, D, IN_COLS, GLOW_COL + GATE_RANK + 32 * nb, F.Win_t, 1536 + 32 * nb, kb, scr, F.lane); continue; } r -= I_INB;
        if (r < I_OUT) { const int kb = r / 32, nb = r % 32; p0_transpose_item(F.w_out, D, D, 32 * nb, F.Wout_t, 32 * nb, kb, scr, F.lane); continue; } r -= I_OUT;
        if (r < I_G) { const int kb = r / 88, nb = r % 88, f0 = 32 * nb; p0_transpose_item(F.w_gate, D, FF, f0, F.Wgu_t, 256 * (f0 / 128) + (f0 % 128), kb, scr, F.lane); continue; } r -= I_G;
        if (r < I_U) { const int kb = r / 88, nb = r % 88, f0 = 32 * nb; p0_transpose_item(F.w_up, D, FF, f0, F.Wgu_t, 256 * (f0 / 128) + 128 + (f0 % 128), kb, scr, F.lane); continue; } r -= I_U;
        { const int kb = r / 32, nb = r % 32; p0_transpose_item(F.w_down, FF, D, 32 * nb, F.Wdn_t, 32 * nb, kb, scr, F.lane); }
    }
    for (int idx = (F.vcu * NWAVES * 64 + F.tid); idx < 256 * (D / 8); idx += F.G * NWAVES * 64) {
        const int n = idx / (D / 8), k0 = (idx % (D / 8)) * 8;
        float up[GATE_RANK];
#pragma unroll
        for (int r = 0; r < GATE_RANK; ++r) up[r] = F.w_gk_up[r * 256 + n];
        float o[8];
#pragma unroll
        for (int kk = 0; kk < 8; ++kk) { const float* wr = F.w_in + (size_t)(k0 + kk) * IN_COLS + GLOW_COL; float s = 0.f;
#pragma unroll
            for (int r = 0; r < GATE_RANK; ++r) s += wr[r] * up[r];
            o[kk] = s; }
        v4u w; w.x = pk2(o[0], o[1]); w.y = pk2(o[2], o[3]); w.z = pk2(o[4], o[5]); w.w = pk2(o[6], o[7]);
        *(GAS v4u*)(F.Win_t + (size_t)(PC_LA + n) * D + k0) = w;
    }
    for (int m = gw; m < M; m += NGW) rms_row_to_bf16(F.x + (size_t)m * D, F.pre_mix_g, F.XN + (size_t)m * D, F.lane);
}
__device__ __forceinline__ void p3b_rows(Frame& F) {
    const int gw = F.vcu * NWAVES + F.wave, NGW = F.G * NWAVES;
    for (int m = gw; m < M; m += NGW) {
        const GAS f32x4* tr = (const GAS f32x4*)(F.TMP + (size_t)m * D) + F.lane; const GAS f32x4* xr = (const GAS f32x4*)(F.x + (size_t)m * D) + F.lane;
        const GAS f32x4* g1 = (const GAS f32x4*)F.post_mix_g + F.lane; const GAS f32x4* g2 = (const GAS f32x4*)F.pre_ffn_g + F.lane;
        f32x4 v[4]; float s = 0.f;
#pragma unroll
        for (int j = 0; j < 4; ++j) { v[j] = tr[64 * j]; s += (v[j].x * v[j].x + v[j].y * v[j].y) + (v[j].z * v[j].z + v[j].w * v[j].w); }
        const float rstd = 1.0f / sqrtf(wave_sum(s) * (1.f / D) + EPS); float s2 = 0.f;
        GAS f32x4* orow = (GAS f32x4*)(F.out + (size_t)m * D) + F.lane;
#pragma unroll
        for (int j = 0; j < 4; ++j) { v[j] = xr[64 * j] + v[j] * rstd * g1[64 * j]; orow[64 * j] = v[j]; s2 += (v[j].x * v[j].x + v[j].y * v[j].y) + (v[j].z * v[j].z + v[j].w * v[j].w); }
        const float rstd2 = 1.0f / sqrtf(wave_sum(s2) * (1.f / D) + EPS);
        GAS unsigned long long* o8 = (GAS unsigned long long*)(F.XN + (size_t)m * D) + F.lane;
#pragma unroll
        for (int j = 0; j < 4; ++j) { const f32x4 y = v[j] * rstd2 * g2[64 * j]; o8[64 * j] = (unsigned long long)pk2(y.x, y.y) | ((unsigned long long)pk2(y.z, y.w) << 32); }
    }
}
__device__ __forceinline__ void p5b_rows(Frame& F) {
    const int gw = F.vcu * NWAVES + F.wave, NGW = F.G * NWAVES;
    for (int m = gw; m < M; m += NGW) {
        const GAS f32x4* tr = (const GAS f32x4*)(F.TMP + (size_t)m * D) + F.lane; GAS f32x4* orow = (GAS f32x4*)(F.out + (size_t)m * D) + F.lane;
        const GAS f32x4* g1 = (const GAS f32x4*)F.post_ffn_g + F.lane;
        f32x4 v[4]; float s = 0.f;
#pragma unroll
        for (int j = 0; j < 4; ++j) { v[j] = tr[64 * j]; s += (v[j].x * v[j].x + v[j].y * v[j].y) + (v[j].z * v[j].z + v[j].w * v[j].w); }
        const float rstd = 1.0f / sqrtf(wave_sum(s) * (1.f / D) + EPS);
#pragma unroll
        for (int j = 0; j < 4; ++j) orow[64 * j] = orow[64 * j] + v[j] * rstd * g1[64 * j];
    }
}


namespace mixa {
typedef short bf16x8 __attribute__((ext_vector_type(8)));
typedef short s16x4 __attribute__((ext_vector_type(4)));
typedef float f32x16 __attribute__((ext_vector_type(16)));
typedef unsigned u32x4 __attribute__((ext_vector_type(4)));
typedef float f32x2_t __attribute__((ext_vector_type(2))); typedef __bf16 bf16x2_t __attribute__((ext_vector_type(2)));
typedef short v4i16_t __attribute__((ext_vector_type(4)));
typedef LAS const unsigned char* lcp;
constexpr int A_SLOT = 32768, A_NSLOT = 3, A_LUT = A_SLOT * A_NSLOT, A_WS = A_LUT + 512, A_END = A_WS + 2048;
constexpr float THR = 8.0f;
__device__ __forceinline__ int crow(int r, int hi) { return (r & 3) + 8 * (r >> 2) + 4 * hi; }
__device__ __forceinline__ unsigned cvtpk(float lo, float hi) { f32x2_t v = {lo, hi}; bf16x2_t b = __builtin_convertvector(v, bf16x2_t); return __builtin_bit_cast(unsigned, b); }
__device__ __forceinline__ s16x4 vtr(lcp p) { return __builtin_bit_cast(s16x4, __builtin_amdgcn_ds_read_tr16_b64_v4i16((LAS v4i16_t*)p)); }
__device__ __forceinline__ float swapmax(float m) { auto rr = __builtin_amdgcn_permlane32_swap(__float_as_uint(m), __float_as_uint(m), false, false); return fmaxf(__uint_as_float(rr[0]), __uint_as_float(rr[1])); }
__device__ __forceinline__ float swapsum(float m) { auto rr = __builtin_amdgcn_permlane32_swap(__float_as_uint(m), __float_as_uint(m), false, false); return __uint_as_float(rr[0]) + __uint_as_float(rr[1]); }
#define MIXA_GLDS(g, l) __builtin_amdgcn_global_load_lds((const unsigned*)(g), (LAS unsigned*)(l), 16, 0, 0)

template <bool NEAR, bool BAND>
__device__ __forceinline__ void tile_step(lcp kp, lcp vp, const bf16x8 (&qf)[4], f32x16 (&o)[4], float& mref, float& lsum,
                                          const LAS float* lut, LAS float* wsf, float bias31, int relbase, int r32, int hi) {
    f32x16 p0, p1;
    {
        const bf16x8 a0 = *(const LAS bf16x8*)(kp), a1 = *(const LAS bf16x8*)(kp + 512), a2 = *(const LAS bf16x8*)(kp + 2048), a3 = *(const LAS bf16x8*)(kp + 2048 + 512);
        const f32x16 z = {0.f, 0.f, 0.f, 0.f, 0.f, 0.f, 0.f, 0.f, 0.f, 0.f, 0.f, 0.f, 0.f, 0.f, 0.f, 0.f};
        p0 = __builtin_amdgcn_mfma_f32_32x32x16_bf16(a0, qf[0], z, 0, 0, 0);
        p1 = __builtin_amdgcn_mfma_f32_32x32x16_bf16(a1, qf[0], z, 0, 0, 0);
        p0 = __builtin_amdgcn_mfma_f32_32x32x16_bf16(a2, qf[1], p0, 0, 0, 0);
        p1 = __builtin_amdgcn_mfma_f32_32x32x16_bf16(a3, qf[1], p1, 0, 0, 0);
    }
    __builtin_amdgcn_sched_barrier(0);
    {
        const bf16x8 a0 = *(const LAS bf16x8*)(kp + 4096), a1 = *(const LAS bf16x8*)(kp + 4096 + 512), a2 = *(const LAS bf16x8*)(kp + 6144), a3 = *(const LAS bf16x8*)(kp + 6144 + 512);
        p0 = __builtin_amdgcn_mfma_f32_32x32x16_bf16(a0, qf[2], p0, 0, 0, 0);
        p1 = __builtin_amdgcn_mfma_f32_32x32x16_bf16(a1, qf[2], p1, 0, 0, 0);
        p0 = __builtin_amdgcn_mfma_f32_32x32x16_bf16(a2, qf[3], p0, 0, 0, 0);
        p1 = __builtin_amdgcn_mfma_f32_32x32x16_bf16(a3, qf[3], p1, 0, 0, 0);
    }
    __builtin_amdgcn_sched_barrier(0);
    if (NEAR) {
#pragma unroll
        for (int r4 = 0; r4 < 4; ++r4) {
#pragma unroll
            for (int e = 0; e < 4; ++e) { const int r = r4 * 4 + e;
                const int rel = relbase - ((r & 3) + 8 * (r >> 2));
                const int i0 = min(max(rel, 0), 127), i1 = min(max(rel - 32, 0), 127);
                p0[r] += lut[i0]; p1[r] += lut[i1];
                if (BAND) { if (rel < 0) p0[r] = -INFINITY; if (rel < 32) p1[r] = -INFINITY; } }
            __builtin_amdgcn_sched_barrier(0);
        }
    }
    const float sh = NEAR ? 0.f : bias31;
    float rm = fmaxf(p0[0], p1[0]);
#pragma unroll
    for (int r = 1; r < 16; ++r) rm = fmaxf(rm, fmaxf(p0[r], p1[r]));
    rm = swapmax(rm) + sh;
    if (__any(rm > mref + THR)) {
        const float mnew = fmaxf(mref, rm); const float f = __builtin_amdgcn_exp2f(mref - mnew);
        lsum *= f; mref = mnew;
        if (hi == 0) wsf[r32] = f;
        asm volatile("s_waitcnt lgkmcnt(0)" ::: "memory");
#pragma unroll
        for (int r = 0; r < 16; ++r) { const float fr = wsf[crow(r, hi)];
#pragma unroll
            for (int d0 = 0; d0 < 4; ++d0) o[d0][r] *= fr; }
    }
    __builtin_amdgcn_sched_barrier(0);
    float sacc = 0.f; const float mr = mref - sh;
#pragma unroll
    for (int r = 0; r < 16; ++r) { p0[r] = __builtin_amdgcn_exp2f(p0[r] - mr); p1[r] = __builtin_amdgcn_exp2f(p1[r] - mr); sacc += p0[r] + p1[r]; }
    lsum += sacc;
    bf16x8 pa[4];
    pa[0] = __builtin_bit_cast(bf16x8, (u32x4){cvtpk(p0[0], p0[1]), cvtpk(p0[2], p0[3]), cvtpk(p0[4], p0[5]), cvtpk(p0[6], p0[7])});
    pa[1] = __builtin_bit_cast(bf16x8, (u32x4){cvtpk(p0[8], p0[9]), cvtpk(p0[10], p0[11]), cvtpk(p0[12], p0[13]), cvtpk(p0[14], p0[15])});
    pa[2] = __builtin_bit_cast(bf16x8, (u32x4){cvtpk(p1[0], p1[1]), cvtpk(p1[2], p1[3]), cvtpk(p1[4], p1[5]), cvtpk(p1[6], p1[7])});
    pa[3] = __builtin_bit_cast(bf16x8, (u32x4){cvtpk(p1[8], p1[9]), cvtpk(p1[10], p1[11]), cvtpk(p1[12], p1[13]), cvtpk(p1[14], p1[15])});
#pragma unroll
    for (int d0 = 0; d0 < 4; ++d0) {
        __builtin_amdgcn_sched_barrier(0);
#pragma unroll
        for (int ks = 0; ks < 4; ++ks) {
            const s16x4 lo = vtr(vp + (d0 * 4 + ks) * 1024), hh = vtr(vp + (d0 * 4 + ks) * 1024 + 512);
            const bf16x8 vb = (bf16x8){lo[0], lo[1], lo[2], lo[3], hh[0], hh[1], hh[2], hh[3]};
            o[d0] = __builtin_amdgcn_mfma_f32_32x32x16_bf16(pa[ks], vb, o[d0], 0, 0, 0);
        }
    }
    __builtin_amdgcn_sched_barrier(0);
}

__device__ __forceinline__ void attn_unit(LAS unsigned char* lds, const bf16* PROJ, bf16* MIXED, const float* __restrict__ rel_bias, const float* __restrict__ g_diff,
                                          float lam, int b, int h, int qb) {
    int tid = threadIdx.x; asm volatile("" : "+v"(tid));
    const int lane = tid & 63, r32 = lane & 31, hi = lane >> 5; const int wid = __builtin_amdgcn_readfirstlane(tid >> 6);
    const int rg = wid >> 1, mp = wid & 1;
    const size_t rowbase = (size_t)b * SEQ; const int q0 = qb * 128;
    const bf16* Kg = PROJ + rowbase * NPROJ + PC_DK + h * 128;
    const bf16* Vg = PROJ + rowbase * NPROJ + PC_DV + h * 128;
    const bf16* Qg = PROJ + (rowbase + q0 + rg * 32 + r32) * NPROJ + PC_DQ + h * 128 + mp * 64;
    const int NT = 2 * (qb + 1);
    LAS float* lut = (LAS float*)(lds + A_LUT);
    LAS float* wsf = (LAS float*)(lds + A_WS) + wid * 64;
    if (tid < 128) { const int n = tid; int bucket = n; if (n >= 16) { bucket = 16 + (int)(logf((float)n / 16.0f) / logf(8.0f) * 16.0f); bucket = bucket > 31 ? 31 : bucket; } lut[tid] = rel_bias[bucket * 4 + h] * LOG2E; }
    const float bias31 = rel_bias[31 * 4 + h] * LOG2E;
    const int st0 = wid * 2;
    const bf16* ksrc0 = Kg + (size_t)lane * NPROJ + st0 * 8;
    const bf16* vsrc0 = Vg + (size_t)(16 * (st0 & 3) + (lane >> 2)) * NPROJ + 32 * (st0 >> 2) + 8 * (lane & 3);
#define MIXA_DMA(t, slot) do { const size_t ro_ = (size_t)(t) * 64 * NPROJ; LAS unsigned char* sb_ = lds + (slot) * A_SLOT + st0 * 1024; \
        MIXA_GLDS(ksrc0 + ro_, sb_); MIXA_GLDS(ksrc0 + ro_ + 8, sb_ + 1024); \
        MIXA_GLDS(vsrc0 + ro_, sb_ + 16384); MIXA_GLDS(vsrc0 + ro_ + (size_t)16 * NPROJ, sb_ + 16384 + 1024); } while (0)
    MIXA_DMA(0, 0);
    bf16x8 qf[4];
#pragma unroll
    for (int s = 0; s < 4; ++s) qf[s] = *(const bf16x8*)(Qg + 16 * s + 8 * hi);
#pragma unroll
    for (int s = 0; s < 4; ++s) asm volatile("" : "+v"(qf[s]));
    MIXA_DMA(1, 1);
    f32x16 o[4];
#pragma unroll
    for (int d0 = 0; d0 < 4; ++d0)
#pragma unroll
        for (int r = 0; r < 16; ++r) o[d0][r] = 0.f;
    float mref = -INFINITY, lsum = 0.f;
    const lcp kp0 = (lcp)lds + (mp * 8 + hi) * 1024 + r32 * 16;
    const lcp vp0 = (lcp)lds + 16384 + ((lane >> 4) & 1) * 32 + (lane & 3) * 8 + (4 * hi + ((lane & 15) >> 2)) * 64;
    const int qrel = rg * 32 + r32;
    int sl = 0, t = 0;
#define MIXA_HEAD() \
        if (t + 1 < NT) asm volatile("s_waitcnt vmcnt(4) lgkmcnt(0)\n\ts_barrier" ::: "memory"); \
        else asm volatile("s_waitcnt vmcnt(0) lgkmcnt(0)\n\ts_barrier" ::: "memory"); \
        if (t + 2 < NT) { const int s2 = (sl >= 1) ? sl - 1 : sl + 2; MIXA_DMA(t + 2, s2); } \
        const int relbase = qrel - 4 * hi + 64 * (2 * qb - t);        \
        const lcp kp = kp0 + sl * A_SLOT, vp = vp0 + sl * A_SLOT;
#define MIXA_TAIL() sl = (sl == 2) ? 0 : sl + 1;
    for (; t < NT - 4; ++t) { MIXA_HEAD(); tile_step<false, false>(kp, vp, qf, o, mref, lsum, lut, wsf, bias31, relbase, r32, hi); MIXA_TAIL(); }
    for (; t < NT - 2; ++t) { MIXA_HEAD(); tile_step<true, false>(kp, vp, qf, o, mref, lsum, lut, wsf, bias31, relbase, r32, hi); MIXA_TAIL(); }
    for (; t < NT; ++t) { MIXA_HEAD(); tile_step<true, true>(kp, vp, qf, o, mref, lsum, lut, wsf, bias31, relbase, r32, hi); MIXA_TAIL(); }
#undef MIXA_HEAD
#undef MIXA_TAIL
#undef MIXA_DMA
    const float lt = swapsum(lsum);
    if (hi == 0) wsf[r32] = (mp == 0) ? 1.0f / lt : lam / lt;
    asm volatile("s_waitcnt lgkmcnt(0)" ::: "memory");
#pragma unroll
    for (int r = 0; r < 16; ++r) { const float fa = wsf[crow(r, hi)];
#pragma unroll
        for (int d0 = 0; d0 < 4; ++d0) o[d0][r] *= fa; }
    asm volatile("s_waitcnt lgkmcnt(0)\n\ts_barrier" ::: "memory");
    LAS float* xo = (LAS float*)(lds + rg * 16384);
    if (mp == 1) {
#pragma unroll
        for (int r = 0; r < 16; ++r)
#pragma unroll
            for (int d0 = 0; d0 < 4; ++d0) xo[(r * 4 + d0) * 64 + lane] = o[d0][r];
    }
    asm volatile("s_waitcnt lgkmcnt(0)\n\ts_barrier" ::: "memory");
    if (mp == 0) {
        float ss[16];
#pragma unroll
        for (int r = 0; r < 16; ++r) { float s = 0.f;
#pragma unroll
            for (int d0 = 0; d0 < 4; ++d0) { const float v = o[d0][r] - xo[(r * 4 + d0) * 64 + lane]; o[d0][r] = v; s += v * v; }
            ss[r] = s; }
#pragma unroll
        for (int of = 1; of < 32; of <<= 1)
#pragma unroll
            for (int r = 0; r < 16; ++r) ss[r] += __shfl_xor(ss[r], of);
        float gd[4];
#pragma unroll
        for (int d0 = 0; d0 < 4; ++d0) gd[d0] = g_diff[d0 * 32 + r32] * (1.0f - LAMBDA_INIT);
        LAS bf16* ost = (LAS bf16*)(lds + 65536 + rg * 8192);
#pragma unroll
        for (int r = 0; r < 16; ++r) { const float rstd = 1.0f / sqrtf(ss[r] * (1.f / 128.f) + EPS); const int row = crow(r, hi);
#pragma unroll
            for (int d0 = 0; d0 < 4; ++d0) ost[row * 128 + d0 * 32 + r32] = (bf16)f2bf(o[d0][r] * rstd * gd[d0]); }
        asm volatile("s_waitcnt lgkmcnt(0)" ::: "memory");
        bf16* Ow = MIXED + (rowbase + q0 + rg * 32) * D + 512 + h * 128;
#pragma unroll
        for (int i = 0; i < 8; ++i) { const int idx = i * 64 + lane, row = idx >> 4, ch = idx & 15;
            const u32x4 v = *(const LAS u32x4*)((LAS unsigned char*)ost + row * 256 + ch * 16);
            *(u32x4*)(Ow + (size_t)row * D + ch * 8) = v; }
    }
    asm volatile("s_waitcnt lgkmcnt(0)\n\ts_barrier" ::: "memory");
}
#undef MIXA_GLDS
}

namespace mixg {
typedef short bf16x8 __attribute__((ext_vector_type(8)));
typedef short s16x4 __attribute__((ext_vector_type(4)));
typedef float f32x16 __attribute__((ext_vector_type(16)));
typedef unsigned u32x4 __attribute__((ext_vector_type(4)));
typedef unsigned u32x2 __attribute__((ext_vector_type(2)));
constexpr int RS = 72;
constexpr int G_VT = 0, G_QS = 18432, G_KS = 27648, G_QB = 36864, G_KLT = 46080, G_ST0 = 55296, G_ST1 = 73728, G_OF = 92160, G_TOT = 125952, G_DEC = 128000, G_B8 = 128256;
constexpr int G_QK0 = 131584, G_C0 = 135680, G_RED = 135936, G_END = 136192;
constexpr int OFS = 132;
using mixa::crow; using mixa::cvtpk;

__device__ __forceinline__ void gla_unit(LAS unsigned char* lds, const bf16* PROJ, bf16* MIXED, const float* __restrict__ x, const float* __restrict__ w_in, const float* __restrict__ pre_mix_g,
                                         const float* __restrict__ g_gla, int b, int h) {
    int tid = threadIdx.x; asm volatile("" : "+v"(tid));
    const int lane = tid & 63, r32 = lane & 31, hi = lane >> 5; const int wid = __builtin_amdgcn_readfirstlane(tid >> 6);
    const size_t rowbase = (size_t)b * SEQ;
    LAS bf16* VT = (LAS bf16*)(lds + G_VT); LAS bf16* QS = (LAS bf16*)(lds + G_QS); LAS bf16* KS = (LAS bf16*)(lds + G_KS); LAS bf16* QB = (LAS bf16*)(lds + G_QB); LAS bf16* KLT = (LAS bf16*)(lds + G_KLT);
    LAS float* OF = (LAS float*)(lds + G_OF); LAS float* TOT = (LAS float*)(lds + G_TOT); LAS float* DEC = (LAS float*)(lds + G_DEC); LAS float* B8 = (LAS float*)(lds + G_B8);
    LAS float* QK0 = (LAS float*)(lds + G_QK0); LAS float* C0 = (LAS float*)(lds + G_C0);
    {
        LAS float* Hs = OF;
        LAS float* PART = (LAS float*)(lds + G_ST1);
        { const int t = wid;
            const GAS f32x4* xr = (const GAS f32x4*)(x + (rowbase + t) * D) + lane; const GAS f32x4* gr = (const GAS f32x4*)pre_mix_g + lane;
            f32x4 v[4]; float s = 0.f;
#pragma unroll
            for (int j = 0; j < 4; ++j) { v[j] = xr[64 * j]; s += (v[j].x * v[j].x + v[j].y * v[j].y) + (v[j].z * v[j].z + v[j].w * v[j].w); }
            const float rstd = 1.0f / sqrtf(wave_sum(s) * (1.f / D) + EPS);
#pragma unroll
            for (int j = 0; j < 4; ++j) *(LAS f32x4*)(Hs + t * D + 4 * (lane + 64 * j)) = v[j] * rstd * gr[64 * j];
        }
        for (int i = tid; i < 128 * RS / 2; i += 512) ((LAS unsigned*)(lds + G_ST0))[i] = 0u;
        __syncthreads();
        const int c = tid & 127, kq = tid >> 7;
        const int wc = (c < 64) ? (h * 64 + c) : (256 + h * 64 + (c - 64));
        float acc[GLA_T0];
#pragma unroll
        for (int t = 0; t < GLA_T0; ++t) acc[t] = 0.f;
        const float* wp = w_in + (size_t)(kq * 256) * IN_COLS + wc;
        for (int k = 0; k < 256; k += 4) {
            float w[4];
#pragma unroll
            for (int e = 0; e < 4; ++e) w[e] = wp[(size_t)(k + e) * IN_COLS];
#pragma unroll
            for (int t = 0; t < GLA_T0; ++t) { const f32x4 hv = *(const LAS f32x4*)(Hs + t * D + kq * 256 + k); acc[t] += hv.x * w[0] + hv.y * w[1] + hv.z * w[2] + hv.w * w[3]; }
        }
#pragma unroll
        for (int t = 0; t < GLA_T0; ++t) PART[(kq * GLA_T0 + t) * 128 + c] = acc[t];
        __syncthreads();
#pragma unroll
        for (int i = 0; i < 2; ++i) { const int idx = tid + 512 * i, t = idx >> 7, cc = idx & 127;
            const float s = (PART[(0 * GLA_T0 + t) * 128 + cc] + PART[(1 * GLA_T0 + t) * 128 + cc]) + (PART[(2 * GLA_T0 + t) * 128 + cc] + PART[(3 * GLA_T0 + t) * 128 + cc]);
            QK0[t * 128 + cc] = (cc < 64) ? s * 0.125f : s; }
        __syncthreads();
    }
    const int sd = tid & 63, seg = tid >> 6;
    const bf16* pla = PROJ + (rowbase + 8 * seg) * NPROJ + PC_LA + h * 64 + sd;
    const bf16* pq = PROJ + (rowbase + 8 * seg) * NPROJ + PC_GQ + h * 64 + sd;
    const bf16* pk = PROJ + (rowbase + 8 * seg) * NPROJ + PC_GK + h * 64 + sd;
    const int vt0 = tid >> 4, vc0 = tid & 15;
    const bf16* pv = PROJ + (rowbase + vt0) * NPROJ + PC_GV + h * 128 + vc0 * 8;
    const int erow = tid >> 3, ecg = tid & 7;
    const bf16* pog = PROJ + (rowbase + erow) * NPROJ + PC_GOG + h * 128 + ecg * 16;
    bf16* pout = MIXED + (rowbase + erow) * D + h * 128 + ecg * 16;
    float gg[16];
#pragma unroll
    for (int e = 0; e < 16; ++e) gg[e] = g_gla[ecg * 16 + e];
    bf16 rla[8], rq[8], rk[8]; u32x4 rv[2];
#define MIXG_LOAD(n) do { const size_t ro_ = (size_t)(n) * 64 * NPROJ; \
        _Pragma("unroll") for (int i = 0; i < 8; ++i) { rla[i] = pla[ro_ + (size_t)i * NPROJ]; rq[i] = pq[ro_ + (size_t)i * NPROJ]; rk[i] = pk[ro_ + (size_t)i * NPROJ]; } \
        rv[0] = *(const u32x4*)(pv + ro_); rv[1] = *(const u32x4*)(pv + ro_ + (size_t)32 * NPROJ); } while (0)
    MIXG_LOAD(0);
    f32x16 S;
#pragma unroll
    for (int r = 0; r < 16; ++r) S[r] = 0.f;
    const int ib = wid >> 2, vb = wid & 3, svb = wid >> 1, sdb = wid & 1;
    for (int n = 0; n < SEQ / 64; ++n) {
        const int cur = n & 1;
        LAS bf16* STc = (LAS bf16*)(lds + (cur ? G_ST1 : G_ST0)); LAS bf16* STn = (LAS bf16*)(lds + (cur ? G_ST0 : G_ST1));
        float cs[8]; { float a = 0.f;
#pragma unroll
            for (int i = 0; i < 8; ++i) { a += bf2f(rla[i]); cs[i] = a; } }
        TOT[seg * 64 + sd] = cs[7];
#pragma unroll
        for (int i = 0; i < 2; ++i) { const int t = vt0 + 32 * i;
#pragma unroll
            for (int e = 0; e < 4; ++e) { const unsigned w = rv[i][e]; VT[(vc0 * 8 + 2 * e) * RS + t] = (bf16)(w & 0xffffu); VT[(vc0 * 8 + 2 * e + 1) * RS + t] = (bf16)(w >> 16); } }
        __syncthreads();
        float pre = 0.f, bref = 0.f, blast = 0.f;
#pragma unroll
        for (int s = 0; s < 8; ++s) { const float tv = TOT[s * 64 + sd]; if (s < seg) pre += tv; if (s < 4) bref += tv; blast += tv; }
        {
            unsigned klw[4];
#pragma unroll
            for (int i = 0; i < 8; ++i) { const float bb = pre + cs[i]; const int t = 8 * seg + i; const float q = bf2f(rq[i]), k = bf2f(rk[i]);
                const float e1 = __builtin_amdgcn_exp2f(bb - bref), e2 = __builtin_amdgcn_exp2f(bref - bb), e3 = __builtin_amdgcn_exp2f(blast - bb), e4 = __builtin_amdgcn_exp2f(bb);
                QS[t * RS + sd] = (bf16)f2bf(q * e1); KS[t * RS + sd] = (bf16)f2bf(k * e2); QB[t * RS + sd] = (bf16)f2bf(q * e4);
                const unsigned kl = f2bf(k * e3); if (i & 1) klw[i >> 1] |= kl << 16; else klw[i >> 1] = kl;
                if (n == 0 && seg == 0) B8[i * 64 + sd] = bb; }
            *(LAS u32x4*)(KLT + sd * RS + 8 * seg) = (u32x4){klw[0], klw[1], klw[2], klw[3]};
            if (seg == 0) DEC[sd] = __builtin_amdgcn_exp2f(blast);
        }
        u32x4 rog[2]; { const size_t ro_ = (size_t)n * 64 * NPROJ; rog[0] = *(const u32x4*)(pog + ro_); rog[1] = *(const u32x4*)(pog + ro_ + 8); }
        if (n + 1 < SEQ / 64) MIXG_LOAD(n + 1);
        __syncthreads();
        {
            f32x16 o;
#pragma unroll
            for (int r = 0; r < 16; ++r) o[r] = 0.f;
            const LAS bf16* qsp = QS + (32 * ib + r32) * RS + 8 * hi;
            const LAS bf16* vtp = VT + (32 * vb + r32) * RS + 4 * hi;
#pragma unroll
            for (int jb = 0; jb < 2; ++jb) {
                if (jb <= ib) {
                    f32x16 X;
#pragma unroll
                    for (int r = 0; r < 16; ++r) X[r] = 0.f;
                    const LAS bf16* ksp = KS + (32 * jb + r32) * RS + 8 * hi;
#pragma unroll
                    for (int s = 0; s < 4; ++s) X = __builtin_amdgcn_mfma_f32_32x32x16_bf16(*(const LAS bf16x8*)(ksp + 16 * s), *(const LAS bf16x8*)(qsp + 16 * s), X, 0, 0, 0);
                    if (jb == ib) {
#pragma unroll
                        for (int r = 0; r < 16; ++r) if (crow(r, hi) > r32) X[r] = 0.f;
                    }
#pragma unroll
                    for (int s = 0; s < 2; ++s) {
                        const bf16x8 pa = __builtin_bit_cast(bf16x8, (u32x4){cvtpk(X[8 * s], X[8 * s + 1]), cvtpk(X[8 * s + 2], X[8 * s + 3]), cvtpk(X[8 * s + 4], X[8 * s + 5]), cvtpk(X[8 * s + 6], X[8 * s + 7])});
                        const u32x2 lo = *(const LAS u32x2*)(vtp + 32 * jb + 16 * s), hh = *(const LAS u32x2*)(vtp + 32 * jb + 16 * s + 8);
                        const bf16x8 vf = __builtin_bit_cast(bf16x8, (u32x4){lo.x, lo.y, hh.x, hh.y});
                        o = __builtin_amdgcn_mfma_f32_32x32x16_bf16(pa, vf, o, 0, 0, 0);
                    }
                }
            }
            const LAS bf16* qbp = QB + (32 * ib + r32) * RS + 8 * hi;
            const LAS bf16* stp = STc + (32 * vb + r32) * RS + 8 * hi;
#pragma unroll
            for (int s = 0; s < 4; ++s) o = __builtin_amdgcn_mfma_f32_32x32x16_bf16(*(const LAS bf16x8*)(qbp + 16 * s), *(const LAS bf16x8*)(stp + 16 * s), o, 0, 0, 0);
#pragma unroll
            for (int r = 0; r < 16; ++r) OF[(32 * ib + crow(r, hi)) * OFS + 32 * vb + r32] = o[r];
            f32x16 U;
#pragma unroll
            for (int r = 0; r < 16; ++r) U[r] = 0.f;
            const LAS bf16* vap = VT + (32 * svb + r32) * RS + 8 * hi;
            const LAS bf16* klp = KLT + (32 * sdb + r32) * RS + 8 * hi;
#pragma unroll
            for (int s = 0; s < 4; ++s) U = __builtin_amdgcn_mfma_f32_32x32x16_bf16(*(const LAS bf16x8*)(vap + 16 * s), *(const LAS bf16x8*)(klp + 16 * s), U, 0, 0, 0);
            const float dec = DEC[32 * sdb + r32];
#pragma unroll
            for (int r = 0; r < 16; ++r) { S[r] = dec * S[r] + U[r]; STn[(32 * svb + crow(r, hi)) * RS + 32 * sdb + r32] = (bf16)f2bf(S[r]); }
        }
        __syncthreads();
        if (n == 0) {
            if (tid < GLA_T0 * GLA_T0) { const int t = tid >> 3, j = tid & 7; float c = 0.f;
                if (j <= t) { for (int d = 0; d < 64; ++d) c += QK0[t * 128 + d] * QK0[j * 128 + 64 + d] * __builtin_amdgcn_exp2f(B8[t * 64 + d] - B8[j * 64 + d]); }
                C0[t * 8 + j] = c; }
            __syncthreads();
#pragma unroll
            for (int i = 0; i < 2; ++i) { const int idx = tid + 512 * i, t = idx >> 7, v = idx & 127; float a = 0.f;
#pragma unroll
                for (int j = 0; j < GLA_T0; ++j) a += C0[t * 8 + j] * bf2f(VT[v * RS + j]);
                OF[t * OFS + v] = a; }
            __syncthreads();
        }
        {
            f32x4 ov[4]; float ss = 0.f;
#pragma unroll
            for (int e = 0; e < 4; ++e) { ov[e] = *(const LAS f32x4*)(OF + erow * OFS + ecg * 16 + 4 * e); ss += (ov[e].x * ov[e].x + ov[e].y * ov[e].y) + (ov[e].z * ov[e].z + ov[e].w * ov[e].w); }
            ss += __shfl_xor(ss, 1); ss += __shfl_xor(ss, 2); ss += __shfl_xor(ss, 4);
            const float rstd = 1.0f / sqrtf(ss * (1.f / 128.f) + EPS);
            unsigned ow[8];
#pragma unroll
            for (int e = 0; e < 8; ++e) { const unsigned w = rog[e >> 2][e & 3];
                const float g0 = __builtin_bit_cast(float, w << 16), g1 = __builtin_bit_cast(float, w & 0xffff0000u);
                const float y0 = ov[e >> 1][(2 * e) & 3] * rstd * gg[2 * e] * (g0 * __builtin_amdgcn_rcpf(1.0f + __builtin_amdgcn_exp2f(-g0 * LOG2E)));
                const float y1 = ov[e >> 1][(2 * e + 1) & 3] * rstd * gg[2 * e + 1] * (g1 * __builtin_amdgcn_rcpf(1.0f + __builtin_amdgcn_exp2f(-g1 * LOG2E)));
                ow[e] = pk2(y0, y1); }
            bf16* po = pout + (size_t)n * 64 * D;
            *(u32x4*)po = (u32x4){ow[0], ow[1], ow[2], ow[3]}; *(u32x4*)(po + 8) = (u32x4){ow[4], ow[5], ow[6], ow[7]};
        }
    }
#undef MIXG_LOAD
    __syncthreads();
}
}

constexpr int CW_QUEUE = 2048;
template <bool WITH_GLA>
__device__ __forceinline__ void p2_mixers(Frame& F) {
    float s1 = 0.f, s2 = 0.f;
    for (int i = 0; i < 64; ++i) { s1 += F.lq1[i] * F.lk1[i]; s2 += F.lq2[i] * F.lk2[i]; }
    const float lam = expf(s1) - expf(s2) + LAMBDA_INIT;
    volatile LAS unsigned* qslot = F.MISC + 16;
    constexpr int NQB = SEQ / 128, NGLA = WITH_GLA ? BATCH * 4 : 0, NATT = BATCH * 4 * NQB, NUNITS = NGLA + NATT;
    for (;;) {
        if (F.tid == 0) { const unsigned u = __hip_atomic_fetch_add(F.ctl + CW_QUEUE, 1u, RLX_AGENT); *qslot = u; }
        __syncthreads();
        const int u = __builtin_amdgcn_readfirstlane((int)*qslot);
        __syncthreads();
        if (u >= NUNITS) break;
        if (u < NGLA) { mixg::gla_unit(F.lds, F.PROJ, F.MIXED, F.x, F.w_in, F.pre_mix_g, F.g_gla, u >> 2, u & 3); }
        else { const int ua = u - NGLA, qb = (NQB - 1) - ua / (BATCH * 4), bh = ua % (BATCH * 4);
            mixa::attn_unit(F.lds, F.PROJ, F.MIXED, F.rel_bias, F.g_diff, lam, bh >> 2, bh & 3, qb); }
    }
}
__global__ void __launch_bounds__(128) naive_gla(const bf16* __restrict__ proj, const float* __restrict__ g_gla, bf16* __restrict__ mixed,
                                                 const float* __restrict__ x, const float* __restrict__ w_in, const float* __restrict__ pre_mix_g) {
    const int bh = blockIdx.x, b = bh >> 2, h = bh & 3, col = threadIdx.x, lane = col & 63, wave = col >> 6;
    __shared__ float red[2][2];
    __shared__ float hrow[D];
    __shared__ float qk0[GLA_T0][128];
    for (int t = 0; t < GLA_T0; ++t) {
        const float* xr = x + ((size_t)b * SEQ + t) * D; float s = 0.f;
        for (int i = col; i < D; i += 128) { const float v = xr[i]; s += v * v; }
        s = wave_sum(s); if (lane == 0) red[0][wave] = s; __syncthreads();
        const float rstd = 1.0f / sqrtf((red[0][0] + red[0][1]) * (1.f / D) + EPS);
        for (int i = col; i < D; i += 128) hrow[i] = xr[i] * rstd * pre_mix_g[i];
        __syncthreads();
        const int wc = (col < 64) ? (h * 64 + col) : (256 + h * 64 + (col - 64));
        float acc = 0.f;
        for (int k = 0; k < D; ++k) acc += hrow[k] * w_in[(size_t)k * IN_COLS + wc];
        qk0[t][col] = (col < 64) ? acc * 0.125f : acc;
        __syncthreads();
    }
    float S[64];
#pragma unroll
    for (int d = 0; d < 64; ++d) S[d] = 0.f;
    const float g = g_gla[col];
    for (int t = 0; t < SEQ; ++t) {
        const size_t row = (size_t)b * SEQ + t; const bf16* pr = proj + row * NPROJ;
        const float v = bf2f(pr[PC_GV + h * 128 + col]), og = bf2f(pr[PC_GOG + h * 128 + col]);
        float o = 0.f;
        if (t < GLA_T0) {
#pragma unroll
            for (int d = 0; d < 64; ++d) { const float a = exp2f(bf2f(pr[PC_LA + h * 64 + d])); const float k = qk0[t][64 + d]; const float q = qk0[t][d];
                S[d] = a * S[d] + k * v; o += q * S[d]; }
        } else {
#pragma unroll
            for (int d = 0; d < 64; ++d) { const float a = exp2f(bf2f(pr[PC_LA + h * 64 + d])); const float k = bf2f(pr[PC_GK + h * 64 + d]); const float q = bf2f(pr[PC_GQ + h * 64 + d]);
                S[d] = a * S[d] + k * v; o += q * S[d]; }
        }
        const float ss = wave_sum(o * o);
        if (lane == 0) red[t & 1][wave] = ss;
        __syncthreads();
        const float tot = red[t & 1][0] + red[t & 1][1];
        const float rstd = 1.0f / sqrtf(tot * (1.f / 128.f) + EPS);
        const float y = o * rstd * g * (og / (1.0f + __expf(-og)));
        mixed[row * D + h * 128 + col] = (bf16)f2bf(y);
    }
}
__global__ void __launch_bounds__(256) naive_attn(const bf16* __restrict__ proj, const float* __restrict__ lq1, const float* __restrict__ lk1, const float* __restrict__ lq2, const float* __restrict__ lk2,
                                                  const float* __restrict__ rel_bias, const float* __restrict__ g_diff, bf16* __restrict__ mixed) {
    __shared__ float Qs[32][129];
    __shared__ float Ks[32][129];
    __shared__ float Vs[32][128];
    __shared__ float As[32][33];
    __shared__ float lut[128];
    const int qt = blockIdx.x, bh = blockIdx.y, b = bh >> 2, h = bh & 3, tid = threadIdx.x, row = tid >> 3, sub = tid & 7;
    const int q0 = qt * 32;
    float s1 = 0.f, s2 = 0.f;
    for (int i = 0; i < 64; ++i) { s1 += lq1[i] * lk1[i]; s2 += lq2[i] * lk2[i]; }
    const float lam = expf(s1) - expf(s2) + LAMBDA_INIT;
    if (tid < 128) { const int n = tid; int bucket = n; if (n >= 16) { bucket = 16 + (int)(logf((float)n / 16.0f) / logf(8.0f) * 16.0f); bucket = bucket > 31 ? 31 : bucket; } lut[tid] = rel_bias[bucket * 4 + h] * LOG2E; }
    const float bias_far = rel_bias[31 * 4 + h] * LOG2E;
    const size_t rb = (size_t)b * SEQ;
    for (int i = 0; i < 16; ++i) { const int idx = tid + 256 * i, r = idx >> 7, c = idx & 127; Qs[r][c] = bf2f(proj[(rb + q0 + r) * NPROJ + PC_DQ + h * 128 + c]); }
    __syncthreads();
    const int qpos = q0 + row, nkt = qt + 1;
    float m1 = -INFINITY, l1 = 0.f, m2 = -INFINITY, l2 = 0.f;
    for (int kt = 0; kt < nkt; ++kt) {
        __syncthreads();
        for (int i = 0; i < 16; ++i) { const int idx = tid + 256 * i, r = idx >> 7, c = idx & 127; Ks[r][c] = bf2f(proj[(rb + kt * 32 + r) * NPROJ + PC_DK + h * 128 + c]); }
        __syncthreads();
        for (int j = 0; j < 4; ++j) { const int key = sub * 4 + j, kpos = kt * 32 + key; float a1 = 0.f, a2 = 0.f;
            for (int d = 0; d < 64; ++d) { a1 += Qs[row][d] * Ks[key][d]; a2 += Qs[row][64 + d] * Ks[key][64 + d]; }
            const int rel = qpos - kpos;
            if (rel >= 0) { const float bias = rel < 128 ? lut[rel] : bias_far; a1 += bias; a2 += bias;
                float mn = fmaxf(m1, a1); l1 = l1 * exp2f(m1 - mn) + exp2f(a1 - mn); m1 = mn;
                mn = fmaxf(m2, a2); l2 = l2 * exp2f(m2 - mn) + exp2f(a2 - mn); m2 = mn; } }
    }
#pragma unroll
    for (int o = 1; o < 8; o <<= 1) {
        const float om1 = __shfl_xor(m1, o), ol1 = __shfl_xor(l1, o), om2 = __shfl_xor(m2, o), ol2 = __shfl_xor(l2, o);
        float mn = fmaxf(m1, om1); l1 = (m1 == -INFINITY ? 0.f : l1 * exp2f(m1 - mn)) + (om1 == -INFINITY ? 0.f : ol1 * exp2f(om1 - mn)); m1 = mn;
        mn = fmaxf(m2, om2); l2 = (m2 == -INFINITY ? 0.f : l2 * exp2f(m2 - mn)) + (om2 == -INFINITY ? 0.f : ol2 * exp2f(om2 - mn)); m2 = mn;
    }
    const float il1 = 1.0f / l1, il2 = lam / l2;
    float o[16];
#pragma unroll
    for (int c = 0; c < 16; ++c) o[c] = 0.f;
    for (int kt = 0; kt < nkt; ++kt) {
        __syncthreads();
        for (int i = 0; i < 16; ++i) { const int idx = tid + 256 * i, r = idx >> 7, c = idx & 127; const size_t base = (rb + kt * 32 + r) * NPROJ;
            Ks[r][c] = bf2f(proj[base + PC_DK + h * 128 + c]); Vs[r][c] = bf2f(proj[base + PC_DV + h * 128 + c]); }
        __syncthreads();
        for (int j = 0; j < 4; ++j) { const int key = sub * 4 + j, kpos = kt * 32 + key; float a1 = 0.f, a2 = 0.f;
            for (int d = 0; d < 64; ++d) { a1 += Qs[row][d] * Ks[key][d]; a2 += Qs[row][64 + d] * Ks[key][64 + d]; }
            const int rel = qpos - kpos; float a = 0.f;
            if (rel >= 0) { const float bias = rel < 128 ? lut[rel] : bias_far; a = exp2f(a1 + bias - m1) * il1 - exp2f(a2 + bias - m2) * il2; }
            As[row][key] = a; }
        __syncthreads();
        for (int key = 0; key < 32; ++key) { const float a = As[row][key];
#pragma unroll
            for (int c = 0; c < 16; ++c) o[c] += a * Vs[key][sub * 16 + c]; }
    }
    float ss = 0.f;
#pragma unroll
    for (int c = 0; c < 16; ++c) ss += o[c] * o[c];
#pragma unroll
    for (int of = 1; of < 8; of <<= 1) ss += __shfl_xor(ss, of);
    const float rstd = 1.0f / sqrtf(ss * (1.f / 128.f) + EPS) * (1.0f - LAMBDA_INIT);
    bf16* orow = mixed + (rb + qpos) * D + 512 + h * 128 + sub * 16;
#pragma unroll
    for (int c = 0; c < 16; ++c) orow[c] = (bf16)f2bf(o[c] * rstd * g_diff[sub * 16 + c]);
}

struct Args { const float* in[19]; float* out; unsigned char* ws; int ph_lo, ph_hi, li, pad; };
__global__ void __launch_bounds__(NWAVES * 64, 2) skel_fwd(Args args) {
    extern __shared__ __attribute__((aligned(16))) unsigned char lds[];
    Frame F;
    F.lds = (LAS unsigned char*)lds;
    F.tid = threadIdx.x; F.lane = F.tid & 63; F.wave = __builtin_amdgcn_readfirstlane(F.tid >> 6);
    F.G = gridDim.x; { const int bx = blockIdx.x; F.vcu = (F.G % 8 == 0) ? (bx % 8) * (F.G / 8) + bx / 8 : bx; }
    unsigned char* ws = args.ws;
    F.x = args.in[0]; F.w_in = args.in[1]; F.w_gk_up = args.in[2]; F.b_gk = args.in[3]; F.lq1 = args.in[4]; F.lk1 = args.in[5]; F.lq2 = args.in[6]; F.lk2 = args.in[7];
    F.rel_bias = args.in[8]; F.g_gla = args.in[9]; F.g_diff = args.in[10]; F.w_out = args.in[11]; F.pre_mix_g = args.in[12]; F.post_mix_g = args.in[13];
    F.w_gate = args.in[14]; F.w_up = args.in[15]; F.w_down = args.in[16]; F.pre_ffn_g = args.in[17]; F.post_ffn_g = args.in[18]; F.out = args.out;
    F.Win_t = (bf16*)(ws + WS_WIN); F.Wout_t = (bf16*)(ws + WS_WOUT); F.Wgu_t = (bf16*)(ws + WS_WGU); F.Wdn_t = (bf16*)(ws + WS_WDN);
    F.PROJ = (bf16*)(ws + WS_PROJ); F.HID = (bf16*)(ws + WS_HID); F.XN = (bf16*)(ws + WS_XN); F.MIXED = (bf16*)(ws + WS_MIXED); F.TMP = (float*)(ws + WS_TMP);
    F.MISC = (volatile LAS unsigned*)(F.lds + MISC_OFF); F.ctl = (gu32*)(ws + WS_CTL);
    for (int u = F.tid; u < (LDS_BYTES - LDSCTL_OFF) / 4; u += NWAVES * 64) ((LAS unsigned*)(F.lds + LDSCTL_OFF))[u] = 0u;
    __syncthreads();
    XcdBarrier bar = xcd_barrier_post((unsigned*)(F.ctl + CW_BAR) + args.li * XCD_BAR_WORDS, F.MISC + 8);
    const int lo = args.ph_lo, hi = args.ph_hi;
#define IN(k) (lo <= (k) && (k) < hi)
#define SEAM(k) do { if (IN(k) && IN((k) + 1)) xcd_barrier(bar); } while (0)
    if (IN(0)) { p0_prologue(F); }
    SEAM(0);
    if (IN(1)) {
        pg8::Gemm g{F.XN, F.Win_t, M, NPROJ, D}; pg8::StaticOrder S; S.init(M, NPROJ, F.G, (int)blockIdx.x);
        pg8::EpiProj E{F.PROJ, NPROJ, F.b_gk};
        pg8::gemm_phase<pg8::EpiProj, pg8::StaticOrder, true, true>(F.lds, g, S, E);
    }
    SEAM(1);
    if (IN(2)) { p2_mixers<true>(F); }
    SEAM(2);
    if (IN(3)) {
        pg8::Gemm g{F.MIXED, F.Wout_t, M, D, D}; pg8::StaticOrder S; S.init(M, D, F.G, (int)blockIdx.x);
        pg8::EpiF32 E{F.TMP, D};
        pg8::gemm_phase<pg8::EpiF32, pg8::StaticOrder, true, true>(F.lds, g, S, E);
    }
    SEAM(3);
    if (IN(4)) { p3b_rows(F); }
    SEAM(4);
    if (IN(5)) {
        pg8::Gemm g{F.XN, F.Wgu_t, M, NGU, D}; pg8::StaticOrder S; S.init(M, NGU, F.G, (int)blockIdx.x);
        pg8::EpiSwiGLU E{F.HID, FF};
        pg8::gemm_phase<pg8::EpiSwiGLU, pg8::StaticOrder, true, true>(F.lds, g, S, E);
    }
    SEAM(5);
    if (IN(6)) {
        pg8::Gemm g{F.HID, F.Wdn_t, M, D, FF}; pg8::StaticOrder S; S.init(M, D, F.G, (int)blockIdx.x);
        pg8::EpiF32 E{F.TMP, D};
        pg8::gemm_phase<pg8::EpiF32, pg8::StaticOrder, true, true>(F.lds, g, S, E);
    }
    SEAM(6);
    if (IN(7)) { p5b_rows(F); }
#undef IN
#undef SEAM
}

extern "C" void kernel_launch(void* const* d_in, const int* in_sizes, int n_in, void* d_out, int out_size, void* d_ws, size_t ws_size, hipStream_t stream) {
    static int grid = 0;
    if (grid == 0) {
        if (n_in != 19 || in_sizes[0] != M * D || out_size != M * D || ws_size < WS_END) { fprintf(stderr, "kernel_launch: unexpected shapes: n_in %d in0 %d out %d ws %zu\n", n_in, n_in > 0 ? in_sizes[0] : -1, out_size, ws_size); grid = -1; return; }
        int dev = 0, cus = 0;
        if (hipGetDevice(&dev) != hipSuccess || hipDeviceGetAttribute(&cus, hipDeviceAttributeMultiprocessorCount, dev) != hipSuccess) { grid = -1; return; }
        if (hipFuncSetAttribute((const void*)skel_fwd, hipFuncAttributeMaxDynamicSharedMemorySize, LDS_BYTES) != hipSuccess) { fprintf(stderr, "kernel_launch: hipFuncSetAttribute failed\n"); grid = -1; return; }
        grid = cus;
    }
    if (grid < 0) return;
    Args a{};
    for (int i = 0; i < 19; ++i) a.in[i] = (const float*)d_in[i];
    a.out = (float*)d_out; a.ws = (unsigned char*)d_ws;
    if (hipMemsetAsync((char*)d_ws + WS_CTL, 0, CTL_ZERO_BYTES, stream) != hipSuccess) { fprintf(stderr, "kernel_launch: memset failed\n"); return; }
    int nl = 0;
    auto launch = [&](int lo, int hi) { a.ph_lo = lo; a.ph_hi = hi; a.li = nl++; hipLaunchKernelGGL(skel_fwd, dim3(grid), dim3(NWAVES * 64), LDS_BYTES, stream, a); };
    launch(0, 8);
    const bf16* proj = (const bf16*)((unsigned char*)d_ws + WS_PROJ); bf16* mixed = (bf16*)((unsigned char*)d_ws + WS_MIXED);
}
```
